# Optimizing an MI355X kernel written in HIP

```python
import math
import jax, jax.numpy as jnp
from jax import lax
import numpy as np

D_MODEL = 1024
BATCH = 2
SEQ = 16384
DEPTH = 4

GRID_W = 64
CTX_LEN = 256

N_ATT_HEADS = 4
ATT_HEAD_DIM = 64
ATT_V_DIM = 2 * ATT_HEAD_DIM
QK_WIDTH = N_ATT_HEADS * 2 * ATT_HEAD_DIM
ATT_WIDTH = N_ATT_HEADS * ATT_V_DIM
CONV_WIDTH = D_MODEL // 4
CONV_WIDTH_K = 3
FOURIER_WIDTH = D_MODEL // 4
FOURIER_GROUPS = 4
FOURIER_GROUP_DIM = FOURIER_WIDTH // FOURIER_GROUPS

MIX_WIDTH = ATT_WIDTH + CONV_WIDTH + FOURIER_WIDTH
IN_WIDTH = 2 * QK_WIDTH + ATT_WIDTH + 3 * CONV_WIDTH + FOURIER_WIDTH
SPLITS = (QK_WIDTH, 2 * QK_WIDTH, 2 * QK_WIDTH + ATT_WIDTH,
          2 * QK_WIDTH + ATT_WIDTH + CONV_WIDTH,
          2 * QK_WIDTH + ATT_WIDTH + 2 * CONV_WIDTH,
          2 * QK_WIDTH + ATT_WIDTH + 3 * CONV_WIDTH)

D_FF = 4 * D_MODEL
Q_BLOCK = 128
ROPE_BASE = 10000.0
LN_EPS = 1e-5
RMS_EPS = 1e-5
DEEPNORM_ALPHA = (2 * DEPTH) ** 0.25
DEEPNORM_BETA = (8 * DEPTH) ** -0.25

kernel_name = "hymba_diffattn_conv_fnet_deepnorm_trunk"


def layer_norm(x, g, b):
    xf = x.astype(jnp.float32)
    mu = jnp.mean(xf, axis=-1, keepdims=True)
    var = jnp.mean(jnp.square(xf - mu), axis=-1, keepdims=True)
    y = (xf - mu) * lax.rsqrt(var + LN_EPS)
    return (y * g.astype(jnp.float32) + b.astype(jnp.float32)).astype(x.dtype)


def rms_norm(x, w):
    xf = x.astype(jnp.float32)
    y = xf * lax.rsqrt(jnp.mean(jnp.square(xf), axis=-1, keepdims=True) + RMS_EPS)
    return (y * w.astype(jnp.float32)).astype(x.dtype)


def modulate(x, shift, scale):
    return x * (1.0 + scale) + shift


def axial_rope(x, rows, cols):
    half = ATT_HEAD_DIM // 2
    quarter = half // 2
    inv_freq = 1.0 / (ROPE_BASE ** (jnp.arange(0, half, 2, dtype=jnp.float32) / half))

    def rot(xa, pos):
        ang = pos.astype(jnp.float32)[:, None] * inv_freq[None, :]
        cos = jnp.cos(ang)[None, :, None, None, :].astype(xa.dtype)
        sin = jnp.sin(ang)[None, :, None, None, :].astype(xa.dtype)
        x1, x2 = xa[..., :quarter], xa[..., quarter:]
        return jnp.concatenate([x1 * cos - x2 * sin, x2 * cos + x1 * sin], axis=-1)

    return jnp.concatenate([rot(x[..., :half], rows), rot(x[..., half:], cols)], axis=-1)


def split_proj(p):
    B, L, _ = p.shape
    q, k, v, u, gb, gc, f = jnp.split(p, SPLITS, axis=-1)
    q = q.reshape(B, L, N_ATT_HEADS, 2, ATT_HEAD_DIM)
    k = k.reshape(B, L, N_ATT_HEADS, 2, ATT_HEAD_DIM)
    v = v.reshape(B, L, N_ATT_HEADS, ATT_V_DIM)
    return q, k, v, u, gb, gc, f


def diff_attention(q, k, v, lam):
    s = jnp.einsum('bqhpd,bkhpd->bhpqk', q, k).astype(jnp.float32) * (ATT_HEAD_DIM ** -0.5)
    p = jax.nn.softmax(s, axis=-1)
    a = p[:, :, 0] - lam * p[:, :, 1]
    return jnp.einsum('bhqk,bkhe->bqhe', a.astype(v.dtype), v)


def diff_attention_blocked(q, k, v, lam):
    B, L = q.shape[0], q.shape[1]
    nb = L // Q_BLOCK
    qb = q.reshape(B, nb, Q_BLOCK, N_ATT_HEADS, 2, ATT_HEAD_DIM).transpose(1, 0, 2, 3, 4, 5)
    out = lax.map(lambda qi: diff_attention(qi, k, v, lam), qb)
    return out.transpose(1, 0, 2, 3, 4).reshape(B, L, N_ATT_HEADS, ATT_V_DIM)


def diff_head_out(o, subln_w, lam_init):
    B, L = o.shape[0], o.shape[1]
    return (rms_norm(o, subln_w) * (1.0 - lam_init)).reshape(B, L, ATT_WIDTH)


def short_conv(u, gb, gc, w, b):
    z = gc * u
    y = lax.conv_general_dilated(z, w[:, None, :].astype(z.dtype), window_strides=(1,),
                                 padding=((1, 1),), dimension_numbers=('NWC', 'WIO', 'NWC'),
                                 feature_group_count=CONV_WIDTH)
    return gb * (y + b)


def fourier_mix(f):
    B, L, _ = f.shape
    fg = f.reshape(B, L, FOURIER_GROUPS, FOURIER_GROUP_DIM).astype(jnp.float32)
    F = jnp.fft.fftn(fg, axes=(1, 3), norm='ortho')
    return jnp.real(F).reshape(B, L, FOURIER_WIDTH).astype(f.dtype)


def squared_relu_mlp(h, w_up, w_down):
    return jnp.square(jax.nn.relu(h @ w_up)) @ w_down


def setup_inputs(seed: int = 0) -> dict:
    key = jax.random.key(seed)
    ks = jax.random.split(key, 20)
    f32 = jnp.float32
    D = D_MODEL
    x = jax.random.normal(ks[0], (BATCH, SEQ, D), f32)
    c = jax.random.normal(ks[1], (BATCH, D), f32)
    ctx = jax.random.normal(ks[2], (BATCH, CTX_LEN, D), f32)
    c_ctx = jax.random.normal(ks[3], (D,), f32)
    w_mod = jax.random.normal(ks[4], (DEPTH, D, 6 * D), f32) * D ** -0.5
    b_mod = jax.random.normal(ks[5], (DEPTH, 6 * D), f32) * 0.02
    col_scale = jnp.ones((IN_WIDTH,), f32).at[2 * QK_WIDTH:2 * QK_WIDTH + ATT_WIDTH].set(DEEPNORM_BETA)
    w_in = jax.random.normal(ks[6], (DEPTH, D, IN_WIDTH), f32) * D ** -0.5 * col_scale
    diff_lambda = jax.random.normal(ks[7], (DEPTH, 4, ATT_HEAD_DIM), f32) * 0.1
    subln_w = 1.0 + 0.02 * jax.random.normal(ks[8], (DEPTH, ATT_V_DIM), f32)
    conv_w = jax.random.normal(ks[9], (DEPTH, CONV_WIDTH_K, CONV_WIDTH), f32) * CONV_WIDTH_K ** -0.5
    conv_b = jax.random.normal(ks[10], (DEPTH, CONV_WIDTH), f32) * 0.02
    w_out = jax.random.normal(ks[11], (DEPTH, MIX_WIDTH, D), f32) * MIX_WIDTH ** -0.5 * DEEPNORM_BETA
    ln1_g = 1.0 + 0.02 * jax.random.normal(ks[12], (DEPTH, D), f32)
    ln1_b = 0.02 * jax.random.normal(ks[13], (DEPTH, D), f32)
    w_up = jax.random.normal(ks[14], (DEPTH, D, D_FF), f32) * D ** -0.5 * DEEPNORM_BETA
    w_down = jax.random.normal(ks[15], (DEPTH, D_FF, D), f32) * D_FF ** -0.5 * DEEPNORM_BETA
    ln2_g = 1.0 + 0.02 * jax.random.normal(ks[16], (DEPTH, D), f32)
    ln2_b = 0.02 * jax.random.normal(ks[17], (DEPTH, D), f32)
    return {"x": x, "c": c, "ctx": ctx, "c_ctx": c_ctx, "w_mod": w_mod, "b_mod": b_mod,
            "w_in": w_in, "diff_lambda": diff_lambda, "subln_w": subln_w, "conv_w": conv_w,
            "conv_b": conv_b, "w_out": w_out, "ln1_g": ln1_g, "ln1_b": ln1_b, "w_up": w_up,
            "w_down": w_down, "ln2_g": ln2_g, "ln2_b": ln2_b}


def reference(x, c, ctx, c_ctx, w_mod, b_mod, w_in, diff_lambda, subln_w, conv_w, conv_b,
              w_out, ln1_g, ln1_b, w_up, w_down, ln2_g, ln2_b):
    B, S, D = x.shape
    ROWS = S // GRID_W
    rows = jnp.repeat(jnp.arange(ROWS), GRID_W)
    cols = jnp.tile(jnp.arange(GRID_W), ROWS)
    silu_c = jax.nn.silu(c)
    silu_cc = jax.nn.silu(c_ctx)

    for l in range(DEPTH):
        last = l == DEPTH - 1
        mod_x = (silu_c @ w_mod[l] + b_mod[l])[:, None, :]
        mod_c = (silu_cc @ w_mod[l] + b_mod[l])[None, None, :]
        sh1, sc1, g1, sh2, sc2, g2 = jnp.split(mod_x, 6, axis=-1)
        csh1, csc1, cg1, csh2, csc2, cg2 = jnp.split(mod_c, 6, axis=-1)

        lam_init = 0.8 - 0.6 * math.exp(-0.3 * l)
        lam_p = diff_lambda[l].astype(jnp.float32)
        lam = (jnp.exp(jnp.sum(lam_p[0] * lam_p[1])) - jnp.exp(jnp.sum(lam_p[2] * lam_p[3]))
               + lam_init)

        px = modulate(x, sh1, sc1) @ w_in[l]
        pc = modulate(ctx, csh1, csc1) @ w_in[l]
        qx, kx, vx, ux, gbx, gcx, fx = split_proj(px)
        qc, kc, vc, uc, gbc, gcc, fc = split_proj(pc)
        qx = axial_rope(qx, rows, cols)
        kx = axial_rope(kx, rows, cols)
        k_all = jnp.concatenate([kc, kx], axis=1)
        v_all = jnp.concatenate([vc, vx], axis=1)

        ox = diff_attention_blocked(qx, k_all, v_all, lam)
        mix_x = jnp.concatenate([
            diff_head_out(ox, subln_w[l], lam_init),
            short_conv(ux, gbx, gcx, conv_w[l], conv_b[l]),
            fourier_mix(fx)], axis=-1) @ w_out[l]
        x = layer_norm(DEEPNORM_ALPHA * x + g1 * mix_x, ln1_g[l], ln1_b[l])

        x = layer_norm(DEEPNORM_ALPHA * x + g2 * squared_relu_mlp(modulate(x, sh2, sc2), w_up[l], w_down[l]),
                       ln2_g[l], ln2_b[l])

        if not last:
            oc = diff_attention(qc, kc, vc, lam)
            mix_c = jnp.concatenate([
                diff_head_out(oc, subln_w[l], lam_init),
                short_conv(uc, gbc, gcc, conv_w[l], conv_b[l]),
                fourier_mix(fc)], axis=-1) @ w_out[l]
            ctx = layer_norm(DEEPNORM_ALPHA * ctx + cg1 * mix_c, ln1_g[l], ln1_b[l])
            ctx = layer_norm(DEEPNORM_ALPHA * ctx + cg2 * squared_relu_mlp(modulate(ctx, csh2, csc2), w_up[l], w_down[l]),
                             ln2_g[l], ln2_b[l])
    return x
```

```cpp
#include <hip/hip_runtime.h>
#include <hip/hip_cooperative_groups.h>
#include <cstdio>
#include <cstdint>
namespace cg = cooperative_groups;

constexpr int DM = 1024, NBATCH = 2, SEQ = 16384, DEPTH = 4, CTXL = 256;
constexpr int RPB = CTXL + SEQ;
constexpr int MROWS = NBATCH * RPB;
constexpr int NIN = 2560, DFF = 4096;
constexpr int C_Q = 0, C_K = 512, C_V = 1024, C_U = 1536, C_GB = 1792, C_GC = 2048, C_F = 2304;
constexpr float LN_EPS = 1e-5f, RMS_EPS = 1e-5f;
constexpr float DN_ALPHA = 1.681792830507429f;

constexpr size_t WS_WIN = 0;
constexpr size_t WS_WOUT = WS_WIN + (size_t)DEPTH * NIN * DM * 2;
constexpr size_t WS_WUP = WS_WOUT + (size_t)DEPTH * DM * DM * 2;
constexpr size_t WS_WDN = WS_WUP + (size_t)DEPTH * DFF * DM * 2;
constexpr size_t WS_SMALL = WS_WDN + (size_t)DEPTH * DM * DFF * 2;
constexpr size_t SM_MOD = 0;
constexpr size_t SM_ROPEC = SM_MOD + (size_t)DEPTH * 3 * 6144 * 4;
constexpr size_t SM_ROPES = SM_ROPEC + 256 * 16 * 4;
constexpr size_t SM_W0T = SM_ROPES + 256 * 16 * 4;
constexpr size_t SM_W1 = SM_W0T + 128 * 64 * 2;
constexpr size_t SM_W2 = SM_W1 + 256 * 256 * 2;
constexpr size_t SM_WC = SM_W2 + 128 * 256 * 2;
constexpr size_t SM_TW = SM_WC + 256 * 512 * 2;
constexpr size_t SM_END = SM_TW + 128 * 128 * 8;
static_assert(SM_END <= (2u << 20), "small region");
constexpr size_t WS_XC = WS_SMALL + (2u << 20);
constexpr size_t WS_H = WS_XC + (size_t)NBATCH * CTXL * DM * 4;
constexpr size_t WS_MIX = WS_H + (size_t)MROWS * DM * 2;
constexpr size_t WS_R = WS_MIX + (size_t)MROWS * DM * 2;
constexpr size_t R_P = 0, R_OATT = (size_t)MROWS * NIN * 2, R_ZR = R_OATT + (size_t)MROWS * DM * 2, R_ZI = R_ZR + (size_t)MROWS * 256 * 2;
static_assert(R_ZI + (size_t)MROWS * 256 * 2 <= (size_t)MROWS * DFF * 2, "overlay");
constexpr size_t WS_END = WS_R + (size_t)MROWS * DFF * 2;
static_assert(WS_END <= 536870912ull, "workspace");
constexpr size_t YP_PLANE = (size_t)NBATCH * 128 * 128 * 256 * 2;
static_assert(2 * YP_PLANE <= (size_t)MROWS * DM * 2, "Y' planes inside H");

struct Params {
    const float *x, *c, *ctx, *c_ctx, *w_mod, *b_mod, *w_in, *diff_lambda, *subln_w, *conv_w, *conv_b, *w_out, *ln1_g, *ln1_b, *w_up, *w_down, *ln2_g, *ln2_b;
    float* out; unsigned char* ws;
};

namespace pg8 {
#define PG8_LAS __attribute__((address_space(3)))
typedef unsigned short bf16_t;
typedef short bf16x8 __attribute__((ext_vector_type(8)));
typedef float f32x4 __attribute__((ext_vector_type(4)));
typedef unsigned u32x4 __attribute__((ext_vector_type(4)));
constexpr int BM = 256, BK = 64, HALF = 128, HTB = HALF * BK * 2  , STAGE_BYTES = 8 * HTB, NXCD = 8, WGM = 8;

__host__ __device__ __forceinline__ int lds_byte(int r, int c) { const int st = (r >> 4) * 2 + (c >> 5), rr = r & 15, cc = c & 31, ob = rr * 64 + cc * 2; return st * 1024 + (ob ^ (((ob >> 9) & 1) << 5)); }
__host__ __device__ __forceinline__ void stage_rc(int b, int& R, int& C) { const int st = b / 1024, sb = b % 1024, swz = sb ^ (((sb >> 9) & 1) << 5); R = (st >> 1) * 16 + swz / 64; C = (st & 1) * 32 + (swz % 64) / 2; }
__host__ __device__ __forceinline__ int perm32(int rho) { const int n = rho >> 4, i = rho & 15; return 8 * (i >> 2) + 4 * n + (i & 3); }

struct Unit { int pm, pn; };
struct Gemm { const bf16_t* A; const bf16_t* Bt; int M, N, K; };

struct StaticOrder {
    int nM, nN, nwg, G, c;
    __host__ __device__ void init(int M, int N, int G_, int c_) { nM = M / BM; nN = N / BM; nwg = nM * nN; G = G_; c = c_; }
    __host__ __device__ bool next(int i, Unit& u) const {
        const long L = (long)i * G + c; if (L >= nwg) return false;
        int wgid = (int)L; { const int q = nwg / NXCD, r = nwg % NXCD, xcd = wgid % NXCD, off = wgid / NXCD; wgid = (xcd < r ? xcd * (q + 1) : r * (q + 1) + (xcd - r) * q) + off; }
        const int nig = WGM * nN, gid = wgid / nig, fm = gid * WGM, gsz = (nM - fm) < WGM ? (nM - fm) : WGM;
        u.pm = fm + ((wgid % nig) % gsz); u.pn = (wgid % nig) / gsz; return true;
    }
    __device__ __forceinline__ void a_ready(const Unit&) const {}
    __device__ __forceinline__ void done(const Unit&) const {}
};

__device__ __forceinline__ unsigned cvt_pk_bf16(float lo, float hi) { unsigned r; asm volatile("v_cvt_pk_bf16_f32 %0, %1, %2" : "=v"(r) : "v"(lo), "v"(hi)); return r; }
typedef float f32x2 __attribute__((ext_vector_type(2)));
template <class Epi, class Sched, bool ALIGN_EPI = false, bool SP2 = false>
__device__ __forceinline__ void gemm_phase(PG8_LAS unsigned char* lds, const Gemm g, const Sched& S, const Epi& E) {
    int tid_ = threadIdx.x; asm volatile("" : "+v"(tid_));
    const int tid = tid_, wid = __builtin_amdgcn_readfirstlane(tid >> 6), lane = tid & 63, wr = wid >> 2, wc = wid & 3, fr = lane & 15, fq = lane >> 4;
    const int K = g.K, nt = K / BK;
    unsigned voffA[2], voffB[2];
#pragma unroll
    for (int i = 0; i < 2; ++i) { int R, C; stage_rc(tid * 16 + i * 8192, R, C); const int Rb = Epi::PERM ? ((R & ~31) + perm32(R & 31)) : R;
        voffA[i] = (unsigned)(R * K + C) * 2u; voffB[i] = (unsigned)(Rb * K + C) * 2u; }
    const size_t kstep = (size_t)(BK * 2);
    const size_t hstep = (size_t)HALF * K * 2;
    const size_t tstep = 2 * hstep;
    const unsigned ldsw = (unsigned)wid * 1024u;
    const int aoff = lds_byte(wr * 64 + fr, fq * 8), boff = lds_byte(wc * 32 + fr, fq * 8);
#define PG8_SA(b, h) (((b) * 2 + (h)) * HTB)
#define PG8_SB(b, h) ((4 + (b) * 2 + (h)) * HTB)
#define PG8_STAGE(bufoff, gbase, voff) do { _Pragma("unroll") for (int _i = 0; _i < 2; ++_i) \
        __builtin_amdgcn_global_load_lds((const unsigned*)((const char*)(gbase) + (voff)[_i]), (PG8_LAS unsigned*)(lds + (bufoff) + ldsw + _i * 8192), 16, 0, 0); } while (0)
#define PG8_LDA(dst, b, h) do { _Pragma("unroll") for (int m = 0; m < 4; ++m) _Pragma("unroll") for (int k = 0; k < 2; ++k) dst[m][k] = *(const PG8_LAS bf16x8*)(lds + PG8_SA(b, h) + aoff + m * 2048 + k * 1024); } while (0)
#define PG8_LDB(dst, b, h) do { _Pragma("unroll") for (int n = 0; n < 2; ++n) _Pragma("unroll") for (int k = 0; k < 2; ++k) dst[n][k] = *(const PG8_LAS bf16x8*)(lds + PG8_SB(b, h) + boff + n * 2048 + k * 1024); } while (0)
#define PG8_MMA(ai, bj, At, Bt) do { __builtin_amdgcn_s_setprio(1); _Pragma("unroll") for (int m = 0; m < 4; ++m) _Pragma("unroll") for (int n = 0; n < 2; ++n) _Pragma("unroll") for (int k = 0; k < 2; ++k) \
        acc[ai][bj][m][n] = __builtin_amdgcn_mfma_f32_16x16x32_bf16(Bt[n][k], At[m][k], acc[ai][bj][m][n], 0, 0, 0); __builtin_amdgcn_s_setprio(0); } while (0)
#define PG8_WAIT_V(n) asm volatile("s_waitcnt vmcnt(" #n ")" ::: "memory")
#define PG8_WAIT_L(n) asm volatile("s_waitcnt lgkmcnt(" #n ")" ::: "memory")
#define PG8_BAR __builtin_amdgcn_s_barrier()
#define PG8_SCHED __builtin_amdgcn_sched_barrier(0)
    Unit cur, nxt; int ui = 0;
    if (!S.next(0, cur)) return;
    f32x4 acc[2][2][4][2];
#pragma unroll
    for (int a = 0; a < 2; ++a)
#pragma unroll
        for (int b = 0; b < 2; ++b)
#pragma unroll
            for (int m = 0; m < 4; ++m)
#pragma unroll
                for (int n = 0; n < 2; ++n) acc[a][b][m][n] = (f32x4){0.f, 0.f, 0.f, 0.f};
    bf16x8 At[4][2], B0[2][2], B1[2][2];
    const char* cA = (const char*)g.A + (size_t)cur.pm * tstep; const char* cB = (const char*)g.Bt + (size_t)cur.pn * tstep;
    S.a_ready(cur);
    if constexpr (SP2) {
        PG8_STAGE(PG8_SB(0, 0), cB, voffB); PG8_STAGE(PG8_SB(0, 1), cB + hstep, voffB); PG8_STAGE(PG8_SA(0, 0), cA, voffA); PG8_STAGE(PG8_SA(0, 1), cA + hstep, voffA);
        if (wr == 1) PG8_BAR;
        PG8_WAIT_V(2); PG8_BAR;
        PG8_STAGE(PG8_SB(1, 0), cB + kstep, voffB); PG8_STAGE(PG8_SA(1, 0), cA + kstep, voffA); PG8_STAGE(PG8_SB(1, 1), cB + hstep + kstep, voffB);
        PG8_WAIT_V(6); PG8_BAR;
    } else {
        PG8_STAGE(PG8_SB(0, 0), cB, voffB); PG8_STAGE(PG8_SA(0, 0), cA, voffA); PG8_STAGE(PG8_SB(0, 1), cB + hstep, voffB); PG8_STAGE(PG8_SA(0, 1), cA + hstep, voffA);
        if (wr == 1) PG8_BAR;
        PG8_WAIT_V(4); PG8_BAR;
        PG8_STAGE(PG8_SB(1, 0), cB + kstep, voffB); PG8_STAGE(PG8_SA(1, 0), cA + kstep, voffA); PG8_STAGE(PG8_SB(1, 1), cB + hstep + kstep, voffB);
        PG8_WAIT_V(6); PG8_BAR;
    }
    for (;;) {
        const bool has_next = S.next(ui + 1, nxt);
        const char* nA = has_next ? (const char*)g.A + (size_t)nxt.pm * tstep : cA; const char* nB = has_next ? (const char*)g.Bt + (size_t)nxt.pn * tstep : cB;
        for (int t = 0; t < nt; t += 2) {
            const bool last = (t == nt - 2);
            const char* a1 = cA + (size_t)(t + 1) * kstep;
            const char* a2 = last ? nA : cA + (size_t)(t + 2) * kstep; const char* b2 = last ? nB : cB + (size_t)(t + 2) * kstep;
            const char* a3 = a2 + kstep; const char* b3 = b2 + kstep;
            if (last && has_next) S.a_ready(nxt);
            if constexpr (SP2) {
            PG8_LDB(B0, 0, 0); PG8_LDB(B1, 0, 1); PG8_SCHED; PG8_LDA(At, 0, 0); PG8_STAGE(PG8_SA(1, 1), a1 + hstep, voffA);
            PG8_WAIT_V(8); PG8_WAIT_L(0); PG8_BAR; PG8_MMA(0, 0, At, B0); PG8_MMA(0, 1, At, B1); PG8_BAR; PG8_SCHED;
            PG8_LDA(At, 0, 1); PG8_STAGE(PG8_SB(0, 0), b2, voffB); PG8_STAGE(PG8_SB(0, 1), b2 + hstep, voffB); PG8_STAGE(PG8_SA(0, 0), a2, voffA);
            PG8_WAIT_V(8); PG8_WAIT_L(0); PG8_BAR; PG8_MMA(1, 0, At, B0); PG8_MMA(1, 1, At, B1); PG8_BAR; PG8_SCHED;
            PG8_LDB(B0, 1, 0); PG8_LDB(B1, 1, 1); PG8_SCHED; PG8_LDA(At, 1, 0); PG8_STAGE(PG8_SA(0, 1), a2 + hstep, voffA);
            PG8_WAIT_V(8); PG8_WAIT_L(0); PG8_BAR; PG8_MMA(0, 0, At, B0); PG8_MMA(0, 1, At, B1); PG8_BAR; PG8_SCHED;
            PG8_LDA(At, 1, 1); PG8_STAGE(PG8_SB(1, 0), b3, voffB); PG8_STAGE(PG8_SB(1, 1), b3 + hstep, voffB); PG8_STAGE(PG8_SA(1, 0), a3, voffA);
            PG8_WAIT_V(8); PG8_WAIT_L(0); PG8_BAR; PG8_MMA(1, 0, At, B0); PG8_MMA(1, 1, At, B1); PG8_BAR; PG8_SCHED;
            } else {
            PG8_LDB(B0, 0, 0); PG8_SCHED; PG8_LDA(At, 0, 0); PG8_STAGE(PG8_SA(1, 1), a1 + hstep, voffA);
            PG8_WAIT_L(8); PG8_BAR; PG8_WAIT_L(0); PG8_MMA(0, 0, At, B0); PG8_BAR; PG8_SCHED;
            PG8_LDB(B1, 0, 1); PG8_STAGE(PG8_SB(0, 0), b2, voffB);
            PG8_BAR; PG8_WAIT_L(0); PG8_MMA(0, 1, At, B1); PG8_BAR;
            PG8_LDA(At, 0, 1); PG8_STAGE(PG8_SA(0, 0), a2, voffA);
            PG8_BAR; PG8_WAIT_L(0); PG8_MMA(1, 0, At, B0); PG8_BAR; PG8_SCHED;
            PG8_STAGE(PG8_SB(0, 1), b2 + hstep, voffB);
            PG8_WAIT_V(6); PG8_BAR; PG8_MMA(1, 1, At, B1); PG8_BAR;
            PG8_LDB(B0, 1, 0); PG8_SCHED; PG8_LDA(At, 1, 0); PG8_STAGE(PG8_SA(0, 1), a2 + hstep, voffA);
            PG8_WAIT_L(8); PG8_BAR; PG8_WAIT_L(0); PG8_MMA(0, 0, At, B0); PG8_BAR; PG8_SCHED;
            PG8_LDB(B1, 1, 1); PG8_STAGE(PG8_SB(1, 0), b3, voffB);
            PG8_BAR; PG8_WAIT_L(0); PG8_MMA(0, 1, At, B1); PG8_BAR;
            PG8_LDA(At, 1, 1); PG8_STAGE(PG8_SA(1, 0), a3, voffA);
            PG8_BAR; PG8_WAIT_L(0); PG8_MMA(1, 0, At, B0); PG8_BAR; PG8_SCHED;
            PG8_STAGE(PG8_SB(1, 1), b3 + hstep, voffB);
            PG8_WAIT_V(6); PG8_BAR; PG8_MMA(1, 1, At, B1); PG8_BAR;
            }
        }
        if constexpr (ALIGN_EPI) { if (wr == 0) PG8_BAR; }
        if constexpr (!Epi::AFTER_DRAIN) { E(acc, cur, wr, wc, fr, fq); S.done(cur); }
        if (!has_next) break;
#pragma unroll
        for (int a = 0; a < 2; ++a)
#pragma unroll
            for (int b = 0; b < 2; ++b)
#pragma unroll
                for (int m = 0; m < 4; ++m)
#pragma unroll
                    for (int n = 0; n < 2; ++n) acc[a][b][m][n] = (f32x4){0.f, 0.f, 0.f, 0.f};
        cur = nxt; cA = nA; cB = nB; ++ui;
        if constexpr (ALIGN_EPI) { if (wr == 1) PG8_BAR; }
    }
    PG8_WAIT_V(0);
    if constexpr (!ALIGN_EPI) { if (wr == 0) PG8_BAR; }
    PG8_BAR;
    if constexpr (Epi::AFTER_DRAIN) { E.fused(acc, cur, wr, wc, fr, fq, lds, wid, lane); S.done(cur); }
#undef PG8_SA
#undef PG8_SB
#undef PG8_STAGE
#undef PG8_LDA
#undef PG8_LDB
#undef PG8_MMA
#undef PG8_WAIT_V
#undef PG8_WAIT_L
#undef PG8_BAR
#undef PG8_SCHED
}
}

typedef unsigned short bf16_t;
typedef short bf16x8 __attribute__((ext_vector_type(8)));
typedef short s16x4 __attribute__((ext_vector_type(4)));
typedef float f32x4 __attribute__((ext_vector_type(4)));
typedef float f32x2 __attribute__((ext_vector_type(2)));
typedef float f32x16 __attribute__((ext_vector_type(16)));
typedef unsigned u32x4 __attribute__((ext_vector_type(4)));
typedef unsigned u32x2 __attribute__((ext_vector_type(2)));
using pg8::cvt_pk_bf16;
__device__ __forceinline__ bf16_t f2bf(float f) { return (bf16_t)(cvt_pk_bf16(f, f) & 0xffffu); }
__device__ __forceinline__ float bf2f(unsigned v) { return __uint_as_float(v << 16); }
__device__ __forceinline__ float bflo(unsigned w) { return __uint_as_float(w << 16); }
__device__ __forceinline__ float bfhi(unsigned w) { return __uint_as_float(w & 0xffff0000u); }
__device__ __forceinline__ float wave_sum(float v) {
#pragma unroll
    for (int o = 1; o < 64; o <<= 1) v += __shfl_xor(v, o);
    return v;
}
__device__ __forceinline__ int crow(int r, int hi) { return (r & 3) + 8 * (r >> 2) + 4 * hi; }
__device__ __forceinline__ float* xrow2(float* out, unsigned char* ws, int m) {
    const int b = m / RPB, j = m - b * RPB;
    return j < CTXL ? (float*)(ws + WS_XC) + (size_t)(b * CTXL + j) * DM : out + ((size_t)b * SEQ + (j - CTXL)) * DM;
}
__device__ __forceinline__ const float* modvec2(const unsigned char* ws, int l, int m) {
    const int b = m / RPB, j = m - b * RPB; const int s = j < CTXL ? 2 : b;
    return (const float*)(ws + WS_SMALL + SM_MOD) + (size_t)(l * 3 + s) * 6144;
}
#define xrow(p, m) xrow2((p).out, (p).ws, (m))
#define modvec(p, l, m) modvec2((p).ws, (l), (m))

struct EpiIn {
    static constexpr bool PERM = false, AFTER_DRAIN = false;
    bf16_t* P; const float* rc; const float* rs;
    __device__ __forceinline__ void operator()(const f32x4 (&acc)[2][2][4][2], const pg8::Unit& u, int wr, int wc, int fr, int fq) const {
        const int tb = u.pm % 65;
        const bool rope = (tb != 0) && (u.pn < 4);
#pragma unroll
        for (int ai = 0; ai < 2; ++ai)
#pragma unroll
            for (int m = 0; m < 4; ++m) {
                const int lr = ai * 128 + wr * 64 + m * 16 + fr;
                bf16_t* rowp = P + ((size_t)u.pm * 256 + lr) * NIN + u.pn * 256 + wc * 32 + 4 * fq;
                const int t = (tb - 1) * 256 + lr;
                const int pos = (wc & 1) ? (t & 63) : (t >> 6);
                f32x4 cv = (f32x4){1.f, 1.f, 1.f, 1.f}, sv = (f32x4){0.f, 0.f, 0.f, 0.f};
                if (rope) { cv = *(const f32x4*)(rc + pos * 16 + 4 * fq); sv = *(const f32x4*)(rs + pos * 16 + 4 * fq); }
#pragma unroll
                for (int bj = 0; bj < 2; ++bj) {
                    const f32x4 v0 = acc[ai][bj][m][0], v1 = acc[ai][bj][m][1];
                    const f32x4 o0 = v0 * cv - v1 * sv, o1 = v1 * cv + v0 * sv;
                    u32x2 w0, w1; w0.x = cvt_pk_bf16(o0[0], o0[1]); w0.y = cvt_pk_bf16(o0[2], o0[3]); w1.x = cvt_pk_bf16(o1[0], o1[1]); w1.y = cvt_pk_bf16(o1[2], o1[3]);
                    *(u32x2*)(rowp + bj * 128) = w0; *(u32x2*)(rowp + bj * 128 + 16) = w1;
                }
            }
    }
};
struct EpiRes {
    static constexpr bool PERM = false, AFTER_DRAIN = false;
    float* out; unsigned char* ws; int l; int goff;
    __device__ __forceinline__ void operator()(const f32x4 (&acc)[2][2][4][2], const pg8::Unit& u, int wr, int wc, int fr, int fq) const {
        const float* gv = modvec2(ws, l, u.pm * 256) + goff;
        const int col0 = u.pn * 256 + wc * 32 + 4 * fq;
        f32x4 g[2][2];
#pragma unroll
        for (int bj = 0; bj < 2; ++bj)
#pragma unroll
            for (int n = 0; n < 2; ++n) g[bj][n] = *(const f32x4*)(gv + col0 + bj * 128 + n * 16);
        float* xb = xrow2(out, ws, u.pm * 256);
#pragma unroll
        for (int ai = 0; ai < 2; ++ai)
#pragma unroll
            for (int m = 0; m < 4; ++m) {
                float* rp = xb + (size_t)(ai * 128 + wr * 64 + m * 16 + fr) * DM + col0;
#pragma unroll
                for (int bj = 0; bj < 2; ++bj)
#pragma unroll
                    for (int n = 0; n < 2; ++n) { f32x4* q = (f32x4*)(rp + bj * 128 + n * 16); const f32x4 xv = *q; *q = xv * DN_ALPHA + g[bj][n] * acc[ai][bj][m][n]; }
            }
    }
};
struct EpiUp {
    static constexpr bool PERM = false, AFTER_DRAIN = false;
    bf16_t* HID;
    __device__ __forceinline__ void operator()(const f32x4 (&acc)[2][2][4][2], const pg8::Unit& u, int wr, int wc, int fr, int fq) const {
#pragma unroll
        for (int ai = 0; ai < 2; ++ai)
#pragma unroll
            for (int m = 0; m < 4; ++m) {
                bf16_t* rowp = HID + ((size_t)u.pm * 256 + ai * 128 + wr * 64 + m * 16 + fr) * DFF + u.pn * 256 + wc * 32 + 4 * fq;
#pragma unroll
                for (int bj = 0; bj < 2; ++bj)
#pragma unroll
                    for (int n = 0; n < 2; ++n) { f32x4 v = acc[ai][bj][m][n];
                        v[0] = fmaxf(v[0], 0.f); v[1] = fmaxf(v[1], 0.f); v[2] = fmaxf(v[2], 0.f); v[3] = fmaxf(v[3], 0.f); v = v * v;
                        u32x2 w; w.x = cvt_pk_bf16(v[0], v[1]); w.y = cvt_pk_bf16(v[2], v[3]); *(u32x2*)(rowp + bj * 128 + n * 16) = w; }
            }
    }
};

namespace att {
constexpr int NW = 8, QBLK = 32, KVBLK = 64;
constexpr float SCALE = 0.125f, THR = 8.f;
constexpr int LDQ = NIN, LDK = NIN, LDO = DM;
constexpr int SHM_V = KVBLK * 128 * 2, SHM_K = KVBLK * 64 * 2, SHM_ATTN = 2 * SHM_V + 2 * SHM_K + NW * 64 * 4;
#define KSWZ(row, colB) ((row) * 128 + ((colB) ^ (((row) & 7) << 4)))
#define SBAR() __builtin_amdgcn_sched_barrier(0)
__device__ __forceinline__ unsigned cvtpk(float lo, float hi) { unsigned r; asm volatile("v_cvt_pk_bf16_f32 %0, %1, %2" : "=v"(r) : "v"(lo), "v"(hi)); return r; }
__device__ __forceinline__ void partialSM(f32x16& p0, f32x16& p1, float& m_reg, float& mn, float& alpha) {
  constexpr float C = SCALE * 1.4426950408889634f;
  float pmax = p0[0];
#pragma unroll
  for (int r = 1; r < 16; ++r) pmax = fmaxf(pmax, p0[r]);
#pragma unroll
  for (int r = 0; r < 16; ++r) pmax = fmaxf(pmax, p1[r]);
  { auto rr = __builtin_amdgcn_permlane32_swap(__float_as_uint(pmax), __float_as_uint(pmax), false, false);
    pmax = fmaxf(__uint_as_float(rr[0]), __uint_as_float(rr[1])); }
  if (__builtin_expect(__all(pmax - m_reg <= THR / SCALE), 1)) { mn = m_reg; alpha = 1.f; }
  else { mn = fmaxf(m_reg, pmax); alpha = __builtin_amdgcn_exp2f((m_reg - mn) * C); m_reg = mn; }
  float mnC = -mn * C;
#pragma unroll
  for (int r = 0; r < 16; ++r) p0[r] = fmaf(p0[r], C, mnC);
#pragma unroll
  for (int r = 0; r < 16; ++r) p1[r] = fmaf(p1[r], C, mnC);
#pragma unroll
  for (int r = 0; r < 16; ++r) p0[r] = __builtin_amdgcn_exp2f(p0[r]);
}
__device__ __forceinline__ void finishSM(f32x16& p0, f32x16& p1, float alpha, float& l_reg, bf16x8& pa0, bf16x8& pa1, bf16x8& pa2, bf16x8& pa3) {
#pragma unroll
  for (int r = 0; r < 16; ++r) p1[r] = __builtin_amdgcn_exp2f(p1[r]);
  float ps = 0;
#pragma unroll
  for (int r = 0; r < 16; ++r) ps += p0[r];
#pragma unroll
  for (int r = 0; r < 16; ++r) ps += p1[r];
  { auto rr = __builtin_amdgcn_permlane32_swap(__float_as_uint(ps), __float_as_uint(ps), false, false);
    ps = __uint_as_float(rr[0]) + __uint_as_float(rr[1]); }
  l_reg = l_reg * alpha + ps;
#define PK4(P, BASE, OUT) do { unsigned a0 = cvtpk(P[BASE + 0], P[BASE + 1]), a1 = cvtpk(P[BASE + 2], P[BASE + 3]);   \
    unsigned b0 = cvtpk(P[BASE + 4], P[BASE + 5]), b1 = cvtpk(P[BASE + 6], P[BASE + 7]);                              \
    auto r0 = __builtin_amdgcn_permlane32_swap(a0, b0, false, false); auto r1 = __builtin_amdgcn_permlane32_swap(a1, b1, false, false); \
    u32x4 w = {r0[0], r1[0], r0[1], r1[1]}; OUT = *reinterpret_cast<bf16x8*>(&w); } while (0)
  PK4(p0, 0, pa0); PK4(p0, 8, pa1); PK4(p1, 0, pa2); PK4(p1, 8, pa3);
#undef PK4
}
__device__ __forceinline__ void qkt(f32x16& p0, f32x16& p1, const char* Ks, const bf16x8* qr, int r32, int hi) {
  p0 = f32x16{}; p1 = f32x16{};
#pragma unroll
  for (int d0 = 0; d0 < 4; ++d0) { const int cb = (d0 * 16 + hi * 8) * 2;
    bf16x8 b0 = *reinterpret_cast<const bf16x8*>(Ks + KSWZ(r32, cb));
    bf16x8 b1 = *reinterpret_cast<const bf16x8*>(Ks + KSWZ(32 + r32, cb));
    p0 = __builtin_amdgcn_mfma_f32_32x32x16_bf16(b0, qr[d0], p0, 0, 0, 0);
    p1 = __builtin_amdgcn_mfma_f32_32x32x16_bf16(b1, qr[d0], p1, 0, 0, 0); }
}
__device__ __forceinline__ int v_st(int k, int c) { const int kk = (k & ~0xC) | ((k & 4) << 1) | ((k & 8) >> 1); return ((kk >> 3) * 4 + (c >> 5)) * 512 + ((kk & 7) * 32 + (c & 31)) * 2; }
__device__ __forceinline__ int v_rd_base(int lane) { return ((lane & 3) << 3) | (((lane >> 2) & 3) << 6) | (((lane >> 4) & 1) << 5) | (((lane >> 5) & 1) << 8); }
constexpr int v_rd_off(int d0, int ks, int half) { return d0 * 512 + ks * 4096 + half * 2048; }
template <int OFF> __device__ __forceinline__ s16x4 tr_read(int vb) {
  s16x4 r; asm volatile("ds_read_b64_tr_b16 %0, %1 offset:%2" : "=&v"(r) : "v"(vb), "i"(OFF) : "memory"); return r;
}
template <int D0> __device__ __forceinline__ void pv_one(f32x16& od, int vb, bf16x8 pa0, bf16x8 pa1, bf16x8 pa2, bf16x8 pa3) {
  const s16x4 l0 = tr_read<v_rd_off(D0, 0, 0)>(vb), h0 = tr_read<v_rd_off(D0, 0, 1)>(vb), l1 = tr_read<v_rd_off(D0, 1, 0)>(vb), h1 = tr_read<v_rd_off(D0, 1, 1)>(vb);
  const s16x4 l2 = tr_read<v_rd_off(D0, 2, 0)>(vb), h2 = tr_read<v_rd_off(D0, 2, 1)>(vb), l3 = tr_read<v_rd_off(D0, 3, 0)>(vb), h3 = tr_read<v_rd_off(D0, 3, 1)>(vb);
  asm volatile("s_waitcnt lgkmcnt(0)" ::: "memory"); SBAR();
#define PK(L, H) (bf16x8){L[0], L[1], L[2], L[3], H[0], H[1], H[2], H[3]}
  od = __builtin_amdgcn_mfma_f32_32x32x16_bf16(pa0, PK(l0, h0), od, 0, 0, 0);
  od = __builtin_amdgcn_mfma_f32_32x32x16_bf16(pa1, PK(l1, h1), od, 0, 0, 0);
  od = __builtin_amdgcn_mfma_f32_32x32x16_bf16(pa2, PK(l2, h2), od, 0, 0, 0);
  od = __builtin_amdgcn_mfma_f32_32x32x16_bf16(pa3, PK(l3, h3), od, 0, 0, 0);
#undef PK
}
__device__ __forceinline__ void pv_d0(f32x16* o, int vb, bf16x8 pa0, bf16x8 pa1, bf16x8 pa2, bf16x8 pa3) {
  pv_one<0>(o[0], vb, pa0, pa1, pa2, pa3); pv_one<1>(o[1], vb, pa0, pa1, pa2, pa3); pv_one<2>(o[2], vb, pa0, pa1, pa2, pa3); pv_one<3>(o[3], vb, pa0, pa1, pa2, pa3);
}
__device__ __forceinline__ void attn_unit(const bf16_t* Qb, const bf16_t* Kh, const bf16_t* Vh, bf16_t* Ob, int seq, char* lds) {
  int tid_ = threadIdx.x; asm volatile("" : "+v"(tid_));
  const int tid = tid_, wid = tid >> 6, lane = tid & 63, r32 = lane & 31, hi = lane >> 5;
  char* V_lds = lds; char* K_lds = lds + 2 * SHM_V;
  float* ws = (float*)(lds + 2 * SHM_V + 2 * SHM_K) + wid * 64; float* li_l = ws; float* al_l = ws + 32;
  float m_reg = -1e30f, l_reg = 0; f32x16 o[4] = {}; bf16x8 qr[4];
  const bf16_t* Qw = Qb + (long)(wid * QBLK + r32) * LDQ + hi * 8;
#pragma unroll
  for (int d0 = 0; d0 < 4; ++d0) qr[d0] = *reinterpret_cast<const bf16x8*>(Qw + d0 * 16);
  const int sr = tid >> 4, sc = (tid & 15) * 8, vst0 = v_st(sr, sc), vst1 = v_st(32 + sr, sc);
  const int kr = tid >> 3, kc = (tid & 7) * 8, kst = KSWZ(kr, kc * 2);
  const int vb0 = (int)(uintptr_t)V_lds + v_rd_base(lane);
  struct { bf16x8 vs0, vs1, ks0; } sr_[2];
#define SLOAD(i, k0) do { sr_[i].vs0 = *reinterpret_cast<const bf16x8*>(&Vh[(long)((k0) + sr) * LDK + sc]); sr_[i].vs1 = *reinterpret_cast<const bf16x8*>(&Vh[(long)((k0) + 32 + sr) * LDK + sc]); \
    sr_[i].ks0 = *reinterpret_cast<const bf16x8*>(&Kh[(long)((k0) + kr) * LDK + kc]); } while (0)
#define SWRITE(b, i) do { *(bf16x8*)(V_lds + (b) * SHM_V + vst0) = sr_[i].vs0; *(bf16x8*)(V_lds + (b) * SHM_V + vst1) = sr_[i].vs1; \
    *(bf16x8*)(K_lds + (b) * SHM_K + kst) = sr_[i].ks0; } while (0)
#define SWAIT() asm volatile("s_waitcnt vmcnt(3)" ::: "memory")
#define RESC(a) do { if (__any((a) < 1.f)) { if (hi == 0) al_l[r32] = (a); asm volatile("s_waitcnt lgkmcnt(0)" ::: "memory"); \
    _Pragma("unroll") for (int d = 0; d < 4; ++d) _Pragma("unroll") for (int r = 0; r < 16; ++r) o[d][r] *= al_l[crow(r, hi)]; } } while (0)
  f32x16 pA0, pA1, pB0, pB1; float mnA, mnB, alA, alB; bf16x8 pa0, pa1, pa2, pa3; const int NT = seq / KVBLK;
  constexpr int SE = 0, SO = 1;
  SLOAD(SE, 0); asm volatile("s_waitcnt vmcnt(0)" ::: "memory"); SWRITE(0, SE); __syncthreads();
  qkt(pA0, pA1, K_lds, qr, r32, hi); partialSM(pA0, pA1, m_reg, mnA, alA);
  SLOAD(SO, KVBLK); if (2 < NT) SLOAD(SE, 2 * KVBLK);
  SWAIT(); SWRITE(1, SO); __syncthreads();
  for (int j = 1; j + 1 < NT; j += 2) {
    SBAR(); qkt(pB0, pB1, K_lds + SHM_K, qr, r32, hi);
    finishSM(pA0, pA1, alA, l_reg, pa0, pa1, pa2, pa3); SBAR();
    SLOAD(SO, (j + 2) * KVBLK); SBAR();
    pv_d0(o, vb0, pa0, pa1, pa2, pa3); partialSM(pB0, pB1, m_reg, mnB, alB);
    __syncthreads(); SWAIT(); SWRITE(0, SE);
    RESC(alB); __syncthreads();
    SBAR(); qkt(pA0, pA1, K_lds, qr, r32, hi);
    finishSM(pB0, pB1, alB, l_reg, pa0, pa1, pa2, pa3); SBAR();
    if (j + 3 < NT) SLOAD(SE, (j + 3) * KVBLK); SBAR();
    pv_d0(o, vb0 + SHM_V, pa0, pa1, pa2, pa3); partialSM(pA0, pA1, m_reg, mnA, alA);
    __syncthreads(); SWAIT(); SWRITE(1, SO);
    RESC(alA); __syncthreads();
  }
  SBAR(); qkt(pB0, pB1, K_lds + SHM_K, qr, r32, hi);
  finishSM(pA0, pA1, alA, l_reg, pa0, pa1, pa2, pa3); SBAR();
  pv_d0(o, vb0, pa0, pa1, pa2, pa3); partialSM(pB0, pB1, m_reg, mnB, alB);
  __syncthreads(); RESC(alB);
  finishSM(pB0, pB1, alB, l_reg, pa0, pa1, pa2, pa3); SBAR();
  pv_d0(o, vb0 + SHM_V, pa0, pa1, pa2, pa3);
  if (hi == 0) li_l[r32] = l_reg; asm volatile("s_waitcnt lgkmcnt(0)" ::: "memory");
  float rli[16];
#pragma unroll
  for (int r = 0; r < 16; ++r) rli[r] = __builtin_amdgcn_rcpf(li_l[crow(r, hi)]);
  bf16_t* Ow = Ob + (long)(wid * QBLK) * LDO;
#pragma unroll
  for (int r = 0; r < 16; ++r) { const int orow = crow(r, hi);
#pragma unroll
    for (int d0 = 0; d0 < 4; ++d0) Ow[(long)orow * LDO + d0 * 32 + r32] = f2bf(o[d0][r] * rli[r]); }
  __syncthreads();
#undef SLOAD
#undef SWRITE
#undef SWAIT
#undef RESC
}
#undef KSWZ
#undef SBAR
}

#define MFMA32(a, b, c) __builtin_amdgcn_mfma_f32_32x32x16_bf16(a, b, c, 0, 0, 0)
__device__ __forceinline__ bf16x8 ldB_strided(const bf16_t* p, size_t ldb) {
    bf16x8 b;
#pragma unroll
    for (int j = 0; j < 8; ++j) b[j] = (short)p[(size_t)j * ldb];
    return b;
}
__device__ __forceinline__ void four_stage0(const bf16_t* P, const bf16_t* W0T, bf16_t* Zr, bf16_t* Zi, int rt, int g, int lane) {
    const int r = lane & 31, h = lane >> 5;
    const bf16_t* Ap = P + (size_t)(32 * rt + r) * NIN + C_F + 64 * g + 8 * h;
    f32x16 acc[4] = {};
#pragma unroll
    for (int ks = 0; ks < 4; ++ks) { const bf16x8 a = *(const bf16x8*)(Ap + 16 * ks);
#pragma unroll
        for (int ct = 0; ct < 4; ++ct) { const bf16x8 b = *(const bf16x8*)(W0T + (32 * ct + r) * 64 + 16 * ks + 8 * h); acc[ct] = MFMA32(a, b, acc[ct]); } }
#pragma unroll
    for (int ct = 0; ct < 4; ++ct) { bf16_t* Zp = (ct < 2 ? Zr : Zi) + 64 * g + 32 * (ct & 1) + r;
#pragma unroll
        for (int reg = 0; reg < 16; ++reg) Zp[(size_t)(32 * rt + crow(reg, h)) * 256] = f2bf(acc[ct][reg]); }
}
__device__ __forceinline__ void four_stage1(const bf16_t* Zr, const bf16_t* Zi, const bf16_t* W1, const f32x2* tw, bf16_t* Ypr, bf16_t* Ypi, int b, int cb, int lane) {
    const int r = lane & 31, h = lane >> 5; const int n0 = 32 * cb, t2 = n0 >> 8, ch0 = n0 & 255;
    f32x16 acc[8] = {};
#pragma unroll
    for (int part = 0; part < 2; ++part) { const bf16_t* Zp = (part ? Zi : Zr) + (size_t)(b * RPB + CTXL + t2) * 256 + ch0 + r;
        for (int kk = 0; kk < 128; kk += 16) { const bf16x8 bf = ldB_strided(Zp + (size_t)(kk + 8 * h) * (128 * 256), (size_t)128 * 256);
#pragma unroll
            for (int mt = 0; mt < 8; ++mt) { const bf16x8 a = *(const bf16x8*)(W1 + (32 * mt + r) * 256 + part * 128 + kk + 8 * h); acc[mt] = MFMA32(a, bf, acc[mt]); } } }
#pragma unroll
    for (int mt = 0; mt < 4; ++mt)
#pragma unroll
        for (int reg = 0; reg < 16; ++reg) { const int k1 = 32 * mt + crow(reg, h); const f32x2 cs = tw[k1 * 128 + t2];
            const float yr = acc[mt][reg], yi = acc[mt + 4][reg]; const size_t o = ((size_t)(b * 128 + k1) * 128 + t2) * 256 + ch0 + r;
            Ypr[o] = f2bf(cs.x * yr + cs.y * yi); Ypi[o] = f2bf(cs.x * yi - cs.y * yr); }
}
__device__ __forceinline__ void four_stage2(const bf16_t* Ypr, const bf16_t* Ypi, const bf16_t* W2, bf16_t* MIX, int b, int k1, int cb, int lane) {
    const int r = lane & 31, h = lane >> 5;
    f32x16 acc[4] = {};
#pragma unroll
    for (int part = 0; part < 2; ++part) { const bf16_t* Yp = (part ? Ypi : Ypr) + ((size_t)(b * 128 + k1) * 128) * 256 + 32 * cb + r;
        for (int kk = 0; kk < 128; kk += 16) { const bf16x8 bf = ldB_strided(Yp + (size_t)(kk + 8 * h) * 256, 256);
#pragma unroll
            for (int mt = 0; mt < 4; ++mt) { const bf16x8 a = *(const bf16x8*)(W2 + (32 * mt + r) * 256 + part * 128 + kk + 8 * h); acc[mt] = MFMA32(a, bf, acc[mt]); } } }
#pragma unroll
    for (int mt = 0; mt < 4; ++mt)
#pragma unroll
        for (int reg = 0; reg < 16; ++reg) { const int k2 = 32 * mt + crow(reg, h);
            MIX[(size_t)(b * RPB + CTXL + k1 + 128 * k2) * DM + 768 + 32 * cb + r] = f2bf(acc[mt][reg]); }
}
__device__ __forceinline__ void four_ctx(const bf16_t* Zr, const bf16_t* Zi, const bf16_t* WC, bf16_t* MIX, int b, int cb, int lane) {
    const int r = lane & 31, h = lane >> 5;
    f32x16 acc[8] = {};
#pragma unroll
    for (int part = 0; part < 2; ++part) { const bf16_t* Zp = (part ? Zi : Zr) + (size_t)(b * RPB) * 256 + 32 * cb + r;
        for (int kk = 0; kk < 256; kk += 16) { const bf16x8 bf = ldB_strided(Zp + (size_t)(kk + 8 * h) * 256, 256);
#pragma unroll
            for (int mt = 0; mt < 8; ++mt) { const bf16x8 a = *(const bf16x8*)(WC + (32 * mt + r) * 512 + part * 256 + kk + 8 * h); acc[mt] = MFMA32(a, bf, acc[mt]); } } }
#pragma unroll
    for (int mt = 0; mt < 8; ++mt)
#pragma unroll
        for (int reg = 0; reg < 16; ++reg) { const int k = 32 * mt + crow(reg, h);
            MIX[(size_t)(b * RPB + k) * DM + 768 + 32 * cb + r] = f2bf(acc[mt][reg]); }
}

__device__ __forceinline__ void ln_mod_row(float* xr, const float* g, const float* bta, const float* sh, const float* sc, bf16_t* hrow, int lane, bool do_ln) {
    f32x4 v[4]; float s = 0.f;
#pragma unroll
    for (int j = 0; j < 4; ++j) { v[j] = *((const f32x4*)xr + lane + 64 * j); s += (v[j][0] + v[j][1]) + (v[j][2] + v[j][3]); }
    if (do_ln) {
        const float mean = wave_sum(s) * (1.f / DM); float s2 = 0.f;
#pragma unroll
        for (int j = 0; j < 4; ++j) { v[j] = v[j] - mean; s2 += (v[j][0] * v[j][0] + v[j][1] * v[j][1]) + (v[j][2] * v[j][2] + v[j][3] * v[j][3]); }
        const float rstd = 1.f / sqrtf(wave_sum(s2) * (1.f / DM) + LN_EPS);
#pragma unroll
        for (int j = 0; j < 4; ++j) { const f32x4 gg = *((const f32x4*)g + lane + 64 * j), bb = *((const f32x4*)bta + lane + 64 * j); v[j] = v[j] * rstd * gg + bb; }
    }
#pragma unroll
    for (int j = 0; j < 4; ++j) *((f32x4*)xr + lane + 64 * j) = v[j];
    if (sh) {
#pragma unroll
        for (int j = 0; j < 4; ++j) { const f32x4 a = *((const f32x4*)sh + lane + 64 * j), c = *((const f32x4*)sc + lane + 64 * j); const f32x4 y = v[j] * (c + 1.0f) + a;
            u32x2 w; w.x = cvt_pk_bf16(y[0], y[1]); w.y = cvt_pk_bf16(y[2], y[3]); *((u32x2*)hrow + lane + 64 * j) = w; }
    }
}
__device__ __forceinline__ void conv_row(const bf16_t* P, const float* cw, const float* cbias, bf16_t* MIX, int m, int lane) {
    const int j = m % RPB; const bool hp = !(j == 0 || j == CTXL), hn = !(j == CTXL - 1 || j == RPB - 1);
    const bf16_t* pr = P + (size_t)m * NIN + 4 * lane;
    const u32x2 u1 = *(const u32x2*)(pr + C_U), c1 = *(const u32x2*)(pr + C_GC), gb = *(const u32x2*)(pr + C_GB);
    u32x2 u0 = (u32x2){0u, 0u}, c0 = u0, u2 = u0, c2 = u0;
    if (hp) { u0 = *(const u32x2*)(pr - NIN + C_U); c0 = *(const u32x2*)(pr - NIN + C_GC); }
    if (hn) { u2 = *(const u32x2*)(pr + NIN + C_U); c2 = *(const u32x2*)(pr + NIN + C_GC); }
    const f32x4 w0 = *(const f32x4*)(cw + 4 * lane), w1 = *(const f32x4*)(cw + 256 + 4 * lane), w2 = *(const f32x4*)(cw + 512 + 4 * lane), bb = *(const f32x4*)(cbias + 4 * lane);
    const f32x4 z0 = (f32x4){bflo(u0.x) * bflo(c0.x), bfhi(u0.x) * bfhi(c0.x), bflo(u0.y) * bflo(c0.y), bfhi(u0.y) * bfhi(c0.y)};
    const f32x4 z1 = (f32x4){bflo(u1.x) * bflo(c1.x), bfhi(u1.x) * bfhi(c1.x), bflo(u1.y) * bflo(c1.y), bfhi(u1.y) * bfhi(c1.y)};
    const f32x4 z2 = (f32x4){bflo(u2.x) * bflo(c2.x), bfhi(u2.x) * bfhi(c2.x), bflo(u2.y) * bflo(c2.y), bfhi(u2.y) * bfhi(c2.y)};
    const f32x4 gbf = (f32x4){bflo(gb.x), bfhi(gb.x), bflo(gb.y), bfhi(gb.y)};
    const f32x4 y = gbf * (w0 * z0 + w1 * z1 + w2 * z2 + bb);
    u32x2 w; w.x = cvt_pk_bf16(y[0], y[1]); w.y = cvt_pk_bf16(y[2], y[3]);
    *(u32x2*)(MIX + (size_t)m * DM + 512 + 4 * lane) = w;
}
__device__ __forceinline__ void combine_row(const bf16_t* OATT, const float* subw, float lam, float one_m_li, bf16_t* MIX, int m, int lane) {
    const int h = lane >> 4, li = lane & 15;
    const bf16_t* op = OATT + (size_t)m * DM + h * 256 + 8 * li;
    const u32x4 a = *(const u32x4*)op, b = *(const u32x4*)(op + 128);
    float o[8];
    o[0] = bflo(a.x) - lam * bflo(b.x); o[1] = bfhi(a.x) - lam * bfhi(b.x); o[2] = bflo(a.y) - lam * bflo(b.y); o[3] = bfhi(a.y) - lam * bfhi(b.y);
    o[4] = bflo(a.z) - lam * bflo(b.z); o[5] = bfhi(a.z) - lam * bfhi(b.z); o[6] = bflo(a.w) - lam * bflo(b.w); o[7] = bfhi(a.w) - lam * bfhi(b.w);
    float ss = 0.f;
#pragma unroll
    for (int i = 0; i < 8; ++i) ss += o[i] * o[i];
    ss += __shfl_xor(ss, 1); ss += __shfl_xor(ss, 2); ss += __shfl_xor(ss, 4); ss += __shfl_xor(ss, 8);
    const float rs = (1.f / sqrtf(ss * (1.f / 128.f) + RMS_EPS)) * one_m_li;
    const f32x4 w0 = *(const f32x4*)(subw + 8 * li), w1 = *(const f32x4*)(subw + 8 * li + 4);
    u32x4 w; w.x = cvt_pk_bf16(o[0] * rs * w0[0], o[1] * rs * w0[1]); w.y = cvt_pk_bf16(o[2] * rs * w0[2], o[3] * rs * w0[3]);
    w.z = cvt_pk_bf16(o[4] * rs * w1[0], o[5] * rs * w1[1]); w.w = cvt_pk_bf16(o[6] * rs * w1[2], o[7] * rs * w1[3]);
    *(u32x4*)(MIX + (size_t)m * DM + h * 128 + 8 * li) = w;
}

__device__ __forceinline__ void transpose_item(const float* W, int K, int N, bf16_t* WT, float* scr, int item, int lane) {
    const int nblk = N / 32, kb = item / nblk, nb = item % nblk, k0 = 64 * kb, n0 = 32 * nb;
#pragma unroll 8
    for (int i = 0; i < 32; ++i) { const int kk = 2 * i + (lane >> 5); scr[kk * 33 + (lane & 31)] = W[(size_t)(k0 + kk) * N + n0 + (lane & 31)]; }
    asm volatile("s_waitcnt lgkmcnt(0)" ::: "memory");
    const int c = lane & 7;
#pragma unroll
    for (int j = 0; j < 4; ++j) { const int n = (lane >> 3) + 8 * j; const float* s = scr + (8 * c) * 33 + n;
        u32x4 o; o.x = cvt_pk_bf16(s[0 * 33], s[1 * 33]); o.y = cvt_pk_bf16(s[2 * 33], s[3 * 33]); o.z = cvt_pk_bf16(s[4 * 33], s[5 * 33]); o.w = cvt_pk_bf16(s[6 * 33], s[7 * 33]);
        *(u32x4*)(WT + (size_t)(n0 + n) * K + k0 + 8 * c) = o; }
    asm volatile("s_waitcnt lgkmcnt(0)" ::: "memory");
}
__device__ __forceinline__ float siluf(float x) { return x / (1.f + expf(-x)); }

constexpr int LDS_BYTES = 131072 + 1024;
__global__ void __launch_bounds__(512, 2) mega_fwd(Params p) {
    extern __shared__ __attribute__((aligned(16))) unsigned char lds[];
    cg::grid_group grid = cg::this_grid();
    const int tid = threadIdx.x, lane = tid & 63, wid = __builtin_amdgcn_readfirstlane(tid >> 6);
    const int G = gridDim.x, gw = blockIdx.x * 8 + wid, NGW = G * 8;
    unsigned char* ws = p.ws;
    bf16_t* Wt_in = (bf16_t*)(ws + WS_WIN); bf16_t* Wt_out = (bf16_t*)(ws + WS_WOUT); bf16_t* Wt_up = (bf16_t*)(ws + WS_WUP); bf16_t* Wt_dn = (bf16_t*)(ws + WS_WDN);
    float* modv = (float*)(ws + WS_SMALL + SM_MOD); float* ropec = (float*)(ws + WS_SMALL + SM_ROPEC); float* ropes = (float*)(ws + WS_SMALL + SM_ROPES);
    bf16_t* W0T = (bf16_t*)(ws + WS_SMALL + SM_W0T); bf16_t* W1 = (bf16_t*)(ws + WS_SMALL + SM_W1); bf16_t* W2 = (bf16_t*)(ws + WS_SMALL + SM_W2); bf16_t* WC = (bf16_t*)(ws + WS_SMALL + SM_WC);
    f32x2* tw = (f32x2*)(ws + WS_SMALL + SM_TW);
    bf16_t* H = (bf16_t*)(ws + WS_H); bf16_t* MIX = (bf16_t*)(ws + WS_MIX);
    bf16_t* Pb = (bf16_t*)(ws + WS_R + R_P); bf16_t* OATT = (bf16_t*)(ws + WS_R + R_OATT); bf16_t* Zr = (bf16_t*)(ws + WS_R + R_ZR); bf16_t* Zi = (bf16_t*)(ws + WS_R + R_ZI);
    bf16_t* HID = (bf16_t*)(ws + WS_R);
    bf16_t* Ypr = (bf16_t*)(ws + WS_H); bf16_t* Ypi = (bf16_t*)(ws + WS_H + YP_PLANE);
    __attribute__((address_space(3))) unsigned char* lds3 = (__attribute__((address_space(3))) unsigned char*)lds;

    {
        float* scr = (float*)(lds + wid * 16384);
        constexpr int I_IN = (DM / 64) * (NIN / 32), I_OUT = (DM / 64) * (DM / 32), I_UP = (DM / 64) * (DFF / 32), I_DN = (DFF / 64) * (DM / 32), I_L = I_IN + I_OUT + I_UP + I_DN;
        for (int it = gw; it < DEPTH * I_L; it += NGW) {
            const int l = it / I_L; int r = it - l * I_L;
            if (r < I_IN) { transpose_item(p.w_in + (size_t)l * DM * NIN, DM, NIN, Wt_in + (size_t)l * NIN * DM, scr, r, lane); continue; } r -= I_IN;
            if (r < I_OUT) { transpose_item(p.w_out + (size_t)l * DM * DM, DM, DM, Wt_out + (size_t)l * DM * DM, scr, r, lane); continue; } r -= I_OUT;
            if (r < I_UP) { transpose_item(p.w_up + (size_t)l * DM * DFF, DM, DFF, Wt_up + (size_t)l * DFF * DM, scr, r, lane); continue; } r -= I_UP;
            transpose_item(p.w_down + (size_t)l * DFF * DM, DFF, DM, Wt_dn + (size_t)l * DM * DFF, scr, r, lane);
        }
        __syncthreads();
        float* sv = (float*)lds; float* red = (float*)(lds + 12288);
        for (int i = tid; i < 3 * DM; i += 512) { const int s = i >> 10, k = i & 1023; sv[i] = siluf(s < 2 ? p.c[s * DM + k] : p.c_ctx[k]); }
        __syncthreads();
        for (int task = blockIdx.x; task < DEPTH * 96; task += G) {
            const int l = task / 96, n = (task % 96) * 64 + lane;
            const float* wp = p.w_mod + (size_t)l * DM * 6144 + n;
            float a0 = 0.f, a1 = 0.f, a2 = 0.f;
#pragma unroll 8
            for (int k = wid * 128; k < wid * 128 + 128; ++k) { const float wv = wp[(size_t)k * 6144]; a0 += sv[k] * wv; a1 += sv[DM + k] * wv; a2 += sv[2 * DM + k] * wv; }
            red[(wid * 3 + 0) * 64 + lane] = a0; red[(wid * 3 + 1) * 64 + lane] = a1; red[(wid * 3 + 2) * 64 + lane] = a2;
            __syncthreads();
            if (wid < 3) { float s = p.b_mod[l * 6144 + n];
#pragma unroll
                for (int w = 0; w < 8; ++w) s += red[(w * 3 + wid) * 64 + lane];
                modv[(size_t)(l * 3 + wid) * 6144 + n] = s; }
            __syncthreads();
        }
        const int gt = blockIdx.x * 512 + tid, NGT = G * 512;
        for (int i = gt; i < 256 * 16; i += NGT) { const int pos = i >> 4, fi = i & 15; double invf = 1.0; for (int q = 0; q < fi; ++q) invf *= 0.5623413251903491;
            const double rev = (double)pos * invf * 0.15915494309189535; const float fr = (float)(rev - floor(rev));
            ropec[i] = __builtin_amdgcn_cosf(fr); ropes[i] = __builtin_amdgcn_sinf(fr); }
        for (int i = gt; i < 128 * 64; i += NGT) { const int n = i >> 6, c = i & 63; const int m = n & 63; const float fr = (float)((m * c) & 63) * (1.f / 64.f);
            W0T[i] = f2bf((n < 64 ? __builtin_amdgcn_cosf(fr) : -__builtin_amdgcn_sinf(fr)) * 0.125f); }
        for (int i = gt; i < 256 * 256; i += NGT) { const int row = i >> 8, col = i & 255; const int k1 = row & 127, t1 = col & 127, po = row >> 7, pi = col >> 7;
            const float fr = (float)((k1 * t1) & 127) * (1.f / 128.f); const float c = __builtin_amdgcn_cosf(fr), s = __builtin_amdgcn_sinf(fr);
            const float v = po == 0 ? (pi == 0 ? c : s) : (pi == 0 ? -s : c); W1[i] = f2bf(v * 0.08838834764831845f); }
        for (int i = gt; i < 128 * 256; i += NGT) { const int k2 = i >> 8, col = i & 255; const int t2 = col & 127, pi = col >> 7;
            const float fr = (float)((k2 * t2) & 127) * (1.f / 128.f); W2[i] = f2bf((pi == 0 ? __builtin_amdgcn_cosf(fr) : __builtin_amdgcn_sinf(fr)) * 0.08838834764831845f); }
        for (int i = gt; i < 256 * 512; i += NGT) { const int k = i >> 9, col = i & 511; const int t = col & 255, pi = col >> 8;
            const float fr = (float)((k * t) & 255) * (1.f / 256.f); WC[i] = f2bf((pi == 0 ? __builtin_amdgcn_cosf(fr) : __builtin_amdgcn_sinf(fr)) * 0.0625f); }
        for (int i = gt; i < 128 * 128; i += NGT) { const int k1 = i >> 7, t2 = i & 127; const float fr = (float)(k1 * t2) * (1.f / 16384.f);
            tw[i] = (f32x2){__builtin_amdgcn_cosf(fr), __builtin_amdgcn_sinf(fr)}; }
    }
    grid.sync();
    for (int m = gw; m < MROWS; m += NGW) {
        const int b = m / RPB, j = m - b * RPB;
        const float* src = j < CTXL ? p.ctx + (size_t)(b * CTXL + j) * DM : p.x + ((size_t)b * SEQ + (j - CTXL)) * DM;
        float* xr = xrow(p, m); const float* mv = modvec(p, 0, m);
        f32x4 v[4];
#pragma unroll
        for (int q = 0; q < 4; ++q) v[q] = *((const f32x4*)src + lane + 64 * q);
#pragma unroll
        for (int q = 0; q < 4; ++q) { *((f32x4*)xr + lane + 64 * q) = v[q];
            const f32x4 a = *((const f32x4*)mv + lane + 64 * q), c = *((const f32x4*)(mv + DM) + lane + 64 * q); const f32x4 y = v[q] * (c + 1.0f) + a;
            u32x2 w; w.x = cvt_pk_bf16(y[0], y[1]); w.y = cvt_pk_bf16(y[2], y[3]); *((u32x2*)(H + (size_t)m * DM) + lane + 64 * q) = w; }
    }
    grid.sync();

#define PHASE_IDS() int tid_ = threadIdx.x; asm volatile("" : "+v"(tid_)); const int lane = tid_ & 63, wid = __builtin_amdgcn_readfirstlane(tid_ >> 6); const int gw = blockIdx.x * 8 + wid; (void)lane; (void)gw
#pragma nounroll
    for (int l = 0; l < DEPTH; ++l) {
        { pg8::Gemm g{H, Wt_in + (size_t)l * NIN * DM, MROWS, NIN, DM}; pg8::StaticOrder S; S.init(MROWS, NIN, G, (int)blockIdx.x);
          EpiIn E{Pb, ropec, ropes};
          pg8::gemm_phase<EpiIn, pg8::StaticOrder, true, true>(lds3, g, S, E); }
        grid.sync();
        {
            PHASE_IDS();
            for (int uidx = blockIdx.x; uidx < 1024 + 16; uidx += G) {
                int b, h, pm_, qrow0, seq;
                if (uidx < 1024) { const int w = uidx & 255, i = uidx >> 8; const int xg = w & 7, li = w >> 3; b = xg >> 2; h = xg & 3; pm_ = i >> 1; const int qb = (i & 1) * 32 + li;
                    qrow0 = b * RPB + CTXL + qb * 256; seq = RPB; }
                else { const int c = uidx - 1024; b = c >> 3; h = (c >> 1) & 3; pm_ = c & 1; qrow0 = b * RPB; seq = CTXL; }
                const size_t krow0 = (size_t)b * RPB;
                att::attn_unit(Pb + (size_t)qrow0 * NIN + C_Q + h * 128 + pm_ * 64, Pb + krow0 * NIN + C_K + h * 128 + pm_ * 64, Pb + krow0 * NIN + C_V + h * 128,
                               OATT + (size_t)qrow0 * DM + h * 256 + pm_ * 128, seq, (char*)lds);
            }
            const float* cw = p.conv_w + (size_t)l * 3 * 256; const float* cbv = p.conv_b + (size_t)l * 256;
            for (int m = gw; m < MROWS; m += NGW) conv_row(Pb, cw, cbv, MIX, m, lane);
            for (int t = gw; t < (MROWS / 32) * 4; t += NGW) four_stage0(Pb, W0T, Zr, Zi, t >> 2, t & 3, lane);
        }
        grid.sync();
        {
            PHASE_IDS();
            for (int t = gw; t < NBATCH * 1024; t += NGW) four_stage1(Zr, Zi, W1, tw, Ypr, Ypi, t >> 10, t & 1023, lane);
            for (int t = gw; t < NBATCH * 8; t += NGW) four_ctx(Zr, Zi, WC, MIX, t >> 3, t & 7, lane);
            const float* lp = p.diff_lambda + (size_t)l * 256;
            const float s1 = wave_sum(lp[lane] * lp[64 + lane]), s2 = wave_sum(lp[128 + lane] * lp[192 + lane]);
            const float lam_init = 0.8f - 0.6f * expf(-0.3f * (float)l);
            const float lam = expf(s1) - expf(s2) + lam_init;
            const float* subw = p.subln_w + (size_t)l * 128;
            for (int m = gw; m < MROWS; m += NGW) combine_row(OATT, subw, lam, 1.f - lam_init, MIX, m, lane);
        }
        grid.sync();
        { PHASE_IDS(); for (int t = gw; t < NBATCH * 128 * 8; t += NGW) four_stage2(Ypr, Ypi, W2, MIX, t >> 10, (t >> 3) & 127, t & 7, lane); }
        grid.sync();
        { pg8::Gemm g{MIX, Wt_out + (size_t)l * DM * DM, MROWS, DM, DM}; pg8::StaticOrder S; S.init(MROWS, DM, G, (int)blockIdx.x);
          EpiRes E{p.out, p.ws, l, 2048};
          pg8::gemm_phase<EpiRes, pg8::StaticOrder, true, true>(lds3, g, S, E); }
        grid.sync();
        { PHASE_IDS(); for (int m = gw; m < MROWS; m += NGW) { const float* mv = modvec(p, l, m);
            ln_mod_row(xrow(p, m), p.ln1_g + (size_t)l * DM, p.ln1_b + (size_t)l * DM, mv + 3072, mv + 4096, H + (size_t)m * DM, lane, true); } }
        grid.sync();
        { pg8::Gemm g{H, Wt_up + (size_t)l * DFF * DM, MROWS, DFF, DM}; pg8::StaticOrder S; S.init(MROWS, DFF, G, (int)blockIdx.x);
          EpiUp E{HID};
          pg8::gemm_phase<EpiUp, pg8::StaticOrder, true, true>(lds3, g, S, E); }
        grid.sync();
        { pg8::Gemm g{HID, Wt_dn + (size_t)l * DM * DFF, MROWS, DM, DFF}; pg8::StaticOrder S; S.init(MROWS, DM, G, (int)blockIdx.x);
          EpiRes E{p.out, p.ws, l, 5120};
          pg8::gemm_phase<EpiRes, pg8::StaticOrder, true, true>(lds3, g, S, E); }
        grid.sync();
        { PHASE_IDS(); for (int m = gw; m < MROWS; m += NGW) { const bool more = (l + 1 < DEPTH); const float* mv = modvec(p, more ? l + 1 : l, m);
            ln_mod_row(xrow(p, m), p.ln2_g + (size_t)l * DM, p.ln2_b + (size_t)l * DM, more ? mv : nullptr, mv + DM, H + (size_t)m * DM, lane, true); } }
        if (l + 1 < DEPTH) grid.sync();
    }
}

extern "C" void kernel_launch(void* const* d_in, const int* in_sizes, int n_in, void* d_out, int out_size, void* d_ws, size_t ws_size, hipStream_t stream) {
    static int grid = 0;
    if (grid == 0) {
        if (n_in != 18 || out_size != NBATCH * SEQ * DM || ws_size < WS_END) { fprintf(stderr, "kernel_launch: unexpected shapes (n_in %d out %d ws %zu)\n", n_in, out_size, ws_size); grid = -1; return; }
        int dev = 0, cus = 0, per_cu = 0;
        hipGetDevice(&dev); hipDeviceGetAttribute(&cus, hipDeviceAttributeMultiprocessorCount, dev);
        if (hipFuncSetAttribute((const void*)mega_fwd, hipFuncAttributeMaxDynamicSharedMemorySize, LDS_BYTES) != hipSuccess) { fprintf(stderr, "kernel_launch: hipFuncSetAttribute failed\n"); grid = -1; return; }
        hipOccupancyMaxActiveBlocksPerMultiprocessor(&per_cu, (const void*)mega_fwd, 512, LDS_BYTES);
        (void)hipGetLastError();
        if (per_cu < 1) per_cu = 1;
        grid = cus;
        if (grid <= 0) grid = 256;
    }
    if (grid < 0) return;
    Params p{};
    const float** f = (const float**)&p;
    for (int i = 0; i < 18; ++i) f[i] = (const float*)d_in[i];
    p.out = (float*)d_out; p.ws = (unsigned char*)d_ws;
    void* args[] = {&p};
    hipError_t e = hipLaunchCooperativeKernel((const void*)mega_fwd, dim3(grid), dim3(512), args, LDS_BYTES, stream);
    if (e != hipSuccess) fprintf(stderr, "cooperative launch failed: %s (grid %d)\n", hipGetErrorString(e), grid);
}
```

```cpp
#include <hip/hip_runtime.h>
#include <hip/hip_cooperative_groups.h>
#include <cstdio>
#include <cstdint>
namespace cg = cooperative_groups;

constexpr int DM = 1024, NBATCH = 2, SEQ = 16384, DEPTH = 4, CTXL = 256;
constexpr int RPB = CTXL + SEQ;
constexpr int MROWS = NBATCH * RPB;
constexpr int NIN = 2560, DFF = 4096;
constexpr int C_Q = 0, C_K = 512, C_V = 1024, C_U = 1536, C_GB = 1792, C_GC = 2048, C_F = 2304;
constexpr float LN_EPS = 1e-5f, RMS_EPS = 1e-5f;
constexpr float DN_ALPHA = 1.681792830507429f;

constexpr size_t WS_WIN = 0;
constexpr size_t WS_WOUT = WS_WIN + (size_t)DEPTH * NIN * DM * 2;
constexpr size_t WS_WUP = WS_WOUT + (size_t)DEPTH * DM * DM * 2;
constexpr size_t WS_WDN = WS_WUP + (size_t)DEPTH * DFF * DM * 2;
constexpr size_t WS_SMALL = WS_WDN + (size_t)DEPTH * DM * DFF * 2;
constexpr size_t SM_MOD = 0;
constexpr size_t SM_ROPEC = SM_MOD + (size_t)DEPTH * 3 * 6144 * 4;
constexpr size_t SM_ROPES = SM_ROPEC + 256 * 16 * 4;
constexpr size_t SM_W0T = SM_ROPES + 256 * 16 * 4;
constexpr size_t SM_W1 = SM_W0T + 128 * 64 * 2;
constexpr size_t SM_W2 = SM_W1 + 256 * 256 * 2;
constexpr size_t SM_WC = SM_W2 + 128 * 256 * 2;
constexpr size_t SM_TW = SM_WC + 256 * 512 * 2;
constexpr size_t SM_END = SM_TW + 128 * 128 * 8;
static_assert(SM_END <= (2u << 20), "small region");
constexpr size_t WS_XC = WS_SMALL + (2u << 20);
constexpr size_t WS_H = WS_XC + (size_t)NBATCH * CTXL * DM * 4;
constexpr size_t WS_MIX = WS_H + (size_t)MROWS * DM * 2;
constexpr size_t WS_R = WS_MIX + (size_t)MROWS * DM * 2;
constexpr size_t R_P = 0, R_OATT = (size_t)MROWS * NIN * 2, R_ZR = R_OATT + (size_t)MROWS * DM * 2, R_ZI = R_ZR + (size_t)MROWS * 256 * 2;
static_assert(R_ZI + (size_t)MROWS * 256 * 2 <= (size_t)MROWS * DFF * 2, "overlay");
constexpr size_t WS_END = WS_R + (size_t)MROWS * DFF * 2;
static_assert(WS_END <= 536870912ull, "workspace");
constexpr size_t YP_PLANE = (size_t)NBATCH * 128 * 128 * 256 * 2;
static_assert(2 * YP_PLANE <= (size_t)MROWS * DM * 2, "Y' planes inside H");

struct Params {
    const float *x, *c, *ctx, *c_ctx, *w_mod, *b_mod, *w_in, *diff_lambda, *subln_w, *conv_w, *conv_b, *w_out, *ln1_g, *ln1_b, *w_up, *w_down, *ln2_g, *ln2_b;
    float* out; unsigned char* ws;
};

namespace pg8 {
#define PG8_LAS __attribute__((address_space(3)))
typedef unsigned short bf16_t;
typedef short bf16x8 __attribute__((ext_vector_type(8)));
typedef float f32x4 __attribute__((ext_vector_type(4)));
typedef unsigned u32x4 __attribute__((ext_vector_type(4)));
constexpr int BM = 256, BK = 64, HALF = 128, HTB = HALF * BK * 2  , STAGE_BYTES = 8 * HTB, NXCD = 8, WGM = 8;

__host__ __device__ __forceinline__ int lds_byte(int r, int c) { const int st = (r >> 4) * 2 + (c >> 5), rr = r & 15, cc = c & 31, ob = rr * 64 + cc * 2; return st * 1024 + (ob ^ (((ob >> 9) & 1) << 5)); }
__host__ __device__ __forceinline__ void stage_rc(int b, int& R, int& C) { const int st = b / 1024, sb = b % 1024, swz = sb ^ (((sb >> 9) & 1) << 5); R = (st >> 1) * 16 + swz / 64; C = (st & 1) * 32 + (swz % 64) / 2; }
__host__ __device__ __forceinline__ int perm32(int rho) { const int n = rho >> 4, i = rho & 15; return 8 * (i >> 2) + 4 * n + (i & 3); }

struct Unit { int pm, pn; };
struct Gemm { const bf16_t* A; const bf16_t* Bt; int M, N, K; };

struct StaticOrder {
    int nM, nN, nwg, G, c;
    __host__ __device__ void init(int M, int N, int G_, int c_) { nM = M / BM; nN = N / BM; nwg = nM * nN; G = G_; c = c_; }
    __host__ __device__ bool next(int i, Unit& u) const {
        const long L = (long)i * G + c; if (L >= nwg) return false;
        int wgid = (int)L; { const int q = nwg / NXCD, r = nwg % NXCD, xcd = wgid % NXCD, off = wgid / NXCD; wgid = (xcd < r ? xcd * (q + 1) : r * (q + 1) + (xcd - r) * q) + off; }
        const int nig = WGM * nN, gid = wgid / nig, fm = gid * WGM, gsz = (nM - fm) < WGM ? (nM - fm) : WGM;
        u.pm = fm + ((wgid % nig) % gsz); u.pn = (wgid % nig) / gsz; return true;
    }
    __device__ __forceinline__ void a_ready(const Unit&) const {}
    __device__ __forceinline__ void done(const Unit&) const {}
};

__device__ __forceinline__ unsigned cvt_pk_bf16(float lo, float hi) { unsigned r; asm volatile("v_cvt_pk_bf16_f32 %0, %1, %2" : "=v"(r) : "v"(lo), "v"(hi)); return r; }
typedef float f32x2 __attribute__((ext_vector_type(2)));
template <class Epi, class Sched, bool ALIGN_EPI = false, bool SP2 = false>
__device__ __forceinline__ void gemm_phase(PG8_LAS unsigned char* lds, const Gemm g, const Sched& S, const Epi& E) {
    int tid_ = threadIdx.x; asm volatile("" : "+v"(tid_));
    const int tid = tid_, wid = __builtin_amdgcn_readfirstlane(tid >> 6), lane = tid & 63, wr = wid >> 2, wc = wid & 3, fr = lane & 15, fq = lane >> 4;
    const int K = g.K, nt = K / BK;
    unsigned voffA[2], voffB[2];
#pragma unroll
    for (int i = 0; i < 2; ++i) { int R, C; stage_rc(tid * 16 + i * 8192, R, C); const int Rb = Epi::PERM ? ((R & ~31) + perm32(R & 31)) : R;
        voffA[i] = (unsigned)(R * K + C) * 2u; voffB[i] = (unsigned)(Rb * K + C) * 2u; }
    const size_t kstep = (size_t)(BK * 2);
    const size_t hstep = (size_t)HALF * K * 2;
    const size_t tstep = 2 * hstep;
    const unsigned ldsw = (unsigned)wid * 1024u;
    const int aoff = lds_byte(wr * 64 + fr, fq * 8), boff = lds_byte(wc * 32 + fr, fq * 8);
#define PG8_SA(b, h) (((b) * 2 + (h)) * HTB)
#define PG8_SB(b, h) ((4 + (b) * 2 + (h)) * HTB)
#define PG8_STAGE(bufoff, gbase, voff) do { _Pragma("unroll") for (int _i = 0; _i < 2; ++_i) \
        __builtin_amdgcn_global_load_lds((const unsigned*)((const char*)(gbase) + (voff)[_i]), (PG8_LAS unsigned*)(lds + (bufoff) + ldsw + _i * 8192), 16, 0, 0); } while (0)
#define PG8_LDA(dst, b, h) do { _Pragma("unroll") for (int m = 0; m < 4; ++m) _Pragma("unroll") for (int k = 0; k < 2; ++k) dst[m][k] = *(const PG8_LAS bf16x8*)(lds + PG8_SA(b, h) + aoff + m * 2048 + k * 1024); } while (0)
#define PG8_LDB(dst, b, h) do { _Pragma("unroll") for (int n = 0; n < 2; ++n) _Pragma("unroll") for (int k = 0; k < 2; ++k) dst[n][k] = *(const PG8_LAS bf16x8*)(lds + PG8_SB(b, h) + boff + n * 2048 + k * 1024); } while (0)
#define PG8_MMA(ai, bj, At, Bt) do { __builtin_amdgcn_s_setprio(1); _Pragma("unroll") for (int m = 0; m < 4; ++m) _Pragma("unroll") for (int n = 0; n < 2; ++n) _Pragma("unroll") for (int k = 0; k < 2; ++k) \
        acc[ai][bj][m][n] = __builtin_amdgcn_mfma_f32_16x16x32_bf16(Bt[n][k], At[m][k], acc[ai][bj][m][n], 0, 0, 0); __builtin_amdgcn_s_setprio(0); } while (0)
#define PG8_WAIT_V(n) asm volatile("s_waitcnt vmcnt(" #n ")" ::: "memory")
#define PG8_WAIT_L(n) asm volatile("s_waitcnt lgkmcnt(" #n ")" ::: "memory")
#define PG8_BAR __builtin_amdgcn_s_barrier()
#define PG8_SCHED __builtin_amdgcn_sched_barrier(0)
    Unit cur, nxt; int ui = 0;
    if (!S.next(0, cur)) return;
    f32x4 acc[2][2][4][2];
#pragma unroll
    for (int a = 0; a < 2; ++a)
#pragma unroll
        for (int b = 0; b < 2; ++b)
#pragma unroll
            for (int m = 0; m < 4; ++m)
#pragma unroll
                for (int n = 0; n < 2; ++n) acc[a][b][m][n] = (f32x4){0.f, 0.f, 0.f, 0.f};
    bf16x8 At[4][2], B0[2][2], B1[2][2];
    const char* cA = (const char*)g.A + (size_t)cur.pm * tstep; const char* cB = (const char*)g.Bt + (size_t)cur.pn * tstep;
    S.a_ready(cur);
    if constexpr (SP2) {
        PG8_STAGE(PG8_SB(0, 0), cB, voffB); PG8_STAGE(PG8_SB(0, 1), cB + hstep, voffB); PG8_STAGE(PG8_SA(0, 0), cA, voffA); PG8_STAGE(PG8_SA(0, 1), cA + hstep, voffA);
        if (wr == 1) PG8_BAR;
        PG8_WAIT_V(2); PG8_BAR;
        PG8_STAGE(PG8_SB(1, 0), cB + kstep, voffB); PG8_STAGE(PG8_SA(1, 0), cA + kstep, voffA); PG8_STAGE(PG8_SB(1, 1), cB + hstep + kstep, voffB);
        PG8_WAIT_V(6); PG8_BAR;
    } else {
        PG8_STAGE(PG8_SB(0, 0), cB, voffB); PG8_STAGE(PG8_SA(0, 0), cA, voffA); PG8_STAGE(PG8_SB(0, 1), cB + hstep, voffB); PG8_STAGE(PG8_SA(0, 1), cA + hstep, voffA);
        if (wr == 1) PG8_BAR;
        PG8_WAIT_V(4); PG8_BAR;
        PG8_STAGE(PG8_SB(1, 0), cB + kstep, voffB); PG8_STAGE(PG8_SA(1, 0), cA + kstep, voffA); PG8_STAGE(PG8_SB(1, 1), cB + hstep + kstep, voffB);
        PG8_WAIT_V(6); PG8_BAR;
    }
    for (;;) {
        const bool has_next = S.next(ui + 1, nxt);
        const char* nA = has_next ? (const char*)g.A + (size_t)nxt.pm * tstep : cA; const char* nB = has_next ? (const char*)g.Bt + (size_t)nxt.pn * tstep : cB;
        for (int t = 0; t < nt; t += 2) {
            const bool last = (t == nt - 2);
            const char* a1 = cA + (size_t)(t + 1) * kstep;
            const char* a2 = last ? nA : cA + (size_t)(t + 2) * kstep; const char* b2 = last ? nB : cB + (size_t)(t + 2) * kstep;
            const char* a3 = a2 + kstep; const char* b3 = b2 + kstep;
            if (last && has_next) S.a_ready(nxt);
            if constexpr (SP2) {
            PG8_LDB(B0, 0, 0); PG8_LDB(B1, 0, 1); PG8_SCHED; PG8_LDA(At, 0, 0); PG8_STAGE(PG8_SA(1, 1), a1 + hstep, voffA);
            PG8_WAIT_V(8); PG8_WAIT_L(0); PG8_BAR; PG8_MMA(0, 0, At, B0); PG8_MMA(0, 1, At, B1); PG8_BAR; PG8_SCHED;
            PG8_LDA(At, 0, 1); PG8_STAGE(PG8_SB(0, 0), b2, voffB); PG8_STAGE(PG8_SB(0, 1), b2 + hstep, voffB); PG8_STAGE(PG8_SA(0, 0), a2, voffA);
            PG8_WAIT_V(8); PG8_WAIT_L(0); PG8_BAR; PG8_MMA(1, 0, At, B0); PG8_MMA(1, 1, At, B1); PG8_BAR; PG8_SCHED;
            PG8_LDB(B0, 1, 0); PG8_LDB(B1, 1, 1); PG8_SCHED; PG8_LDA(At, 1, 0); PG8_STAGE(PG8_SA(0, 1), a2 + hstep, voffA);
            PG8_WAIT_V(8); PG8_WAIT_L(0); PG8_BAR; PG8_MMA(0, 0, At, B0); PG8_MMA(0, 1, At, B1); PG8_BAR; PG8_SCHED;
            PG8_LDA(At, 1, 1); PG8_STAGE(PG8_SB(1, 0), b3, voffB); PG8_STAGE(PG8_SB(1, 1), b3 + hstep, voffB); PG8_STAGE(PG8_SA(1, 0), a3, voffA);
            PG8_WAIT_V(8); PG8_WAIT_L(0); PG8_BAR; PG8_MMA(1, 0, At, B0); PG8_MMA(1, 1, At, B1); PG8_BAR; PG8_SCHED;
            } else {
            PG8_LDB(B0, 0, 0); PG8_SCHED; PG8_LDA(At, 0, 0); PG8_STAGE(PG8_SA(1, 1), a1 + hstep, voffA);
            PG8_WAIT_L(8); PG8_BAR; PG8_WAIT_L(0); PG8_MMA(0, 0, At, B0); PG8_BAR; PG8_SCHED;
            PG8_LDB(B1, 0, 1); PG8_STAGE(PG8_SB(0, 0), b2, voffB);
            PG8_BAR; PG8_WAIT_L(0); PG8_MMA(0, 1, At, B1); PG8_BAR;
            PG8_LDA(At, 0, 1); PG8_STAGE(PG8_SA(0, 0), a2, voffA);
            PG8_BAR; PG8_WAIT_L(0); PG8_MMA(1, 0, At, B0); PG8_BAR; PG8_SCHED;
            PG8_STAGE(PG8_SB(0, 1), b2 + hstep, voffB);
            PG8_WAIT_V(6); PG8_BAR; PG8_MMA(1, 1, At, B1); PG8_BAR;
            PG8_LDB(B0, 1, 0); PG8_SCHED; PG8_LDA(At, 1, 0); PG8_STAGE(PG8_SA(0, 1), a2 + hstep, voffA);
            PG8_WAIT_L(8); PG8_BAR; PG8_WAIT_L(0); PG8_MMA(0, 0, At, B0); PG8_BAR; PG8_SCHED;
            PG8_LDB(B1, 1, 1); PG8_STAGE(PG8_SB(1, 0), b3, voffB);
            PG8_BAR; PG8_WAIT_L(0); PG8_MMA(0, 1, At, B1); PG8_BAR;
            PG8_LDA(At, 1, 1); PG8_STAGE(PG8_SA(1, 0), a3, voffA);
            PG8_BAR; PG8_WAIT_L(0); PG8_MMA(1, 0, At, B0); PG8_BAR; PG8_SCHED;
            PG8_STAGE(PG8_SB(1, 1), b3 + hstep, voffB);
            PG8_WAIT_V(6); PG8_BAR; PG8_MMA(1, 1, At, B1); PG8_BAR;
            }
        }
        if constexpr (ALIGN_EPI) { if (wr == 0) PG8_BAR; }
        if constexpr (!Epi::AFTER_DRAIN) { E(acc, cur, wr, wc, fr, fq); S.done(cur); }
        if (!has_next) break;
#pragma unroll
        for (int a = 0; a < 2; ++a)
#pragma unroll
            for (int b = 0; b < 2; ++b)
#pragma unroll
                for (int m = 0; m < 4; ++m)
#pragma unroll
                    for (int n = 0; n < 2; ++n) acc[a][b][m][n] = (f32x4){0.f, 0.f, 0.f, 0.f};
        cur = nxt; cA = nA; cB = nB; ++ui;
        if constexpr (ALIGN_EPI) { if (wr == 1) PG8_BAR; }
    }
    PG8_WAIT_V(0);
    if constexpr (!ALIGN_EPI) { if (wr == 0) PG8_BAR; }
    PG8_BAR;
    if constexpr (Epi::AFTER_DRAIN) { E.fused(acc, cur, wr, wc, fr, fq, lds, wid, lane); S.done(cur); }
#undef PG8_SA
#undef PG8_SB
#undef PG8_STAGE
#undef PG8_LDA
#undef PG8_LDB
#undef PG8_MMA
#undef PG8_WAIT_V
#undef PG8_WAIT_L
#undef PG8_BAR
#undef PG8_SCHED
}
}

typedef unsigned short bf16_t;
typedef short bf16x8 __attribute__((ext_vector_type(8)));
typedef short s16x4 __attribute__((ext_vector_type(4)));
typedef float f32x4 __attribute__((ext_vector_type(4)));
typedef float f32x2 __attribute__((ext_vector_type(2)));
typedef float f32x16 __attribute__((ext_vector_type(16)));
typedef unsigned u32x4 __attribute__((ext_vector_type(4)));
typedef unsigned u32x2 __attribute__((ext_vector_type(2)));
using pg8::cvt_pk_bf16;
__device__ __forceinline__ bf16_t f2bf(float f) { return (bf16_t)(cvt_pk_bf16(f, f) & 0xffffu); }
__device__ __forceinline__ float bf2f(unsigned v) { return __uint_as_float(v << 16); }
__device__ __forceinline__ float bflo(unsigned w) { return __uint_as_float(w << 16); }
__device__ __forceinline__ float bfhi(unsigned w) { return __uint_as_float(w & 0xffff0000u); }
__device__ __forceinline__ float wave_sum(float v) {
#pragma unroll
    for (int o = 1; o < 64; o <<= 1) v += __shfl_xor(v, o);
    return v;
}
__device__ __forceinline__ int crow(int r, int hi) { return (r & 3) + 8 * (r >> 2) + 4 * hi; }
__device__ __forceinline__ float* xrow2(float* out, unsigned char* ws, int m) {
    const int b = m / RPB, j = m - b * RPB;
    return j < CTXL ? (float*)(ws + WS_XC) + (size_t)(b * CTXL + j) * DM : out + ((size_t)b * SEQ + (j - CTXL)) * DM;
}
__device__ __forceinline__ const float* modvec2(const unsigned char* ws, int l, int m) {
    const int b = m / RPB, j = m - b * RPB; const int s = j < CTXL ? 2 : b;
    return (const float*)(ws + WS_SMALL + SM_MOD) + (size_t)(l * 3 + s) * 6144;
}
#define xrow(p, m) xrow2((p).out, (p).ws, (m))
#define modvec(p, l, m) modvec2((p).ws, (l), (m))

constexpr float QSCALE = 0.125f * 1.4426950408889634f;
struct EpiIn {
    static constexpr bool PERM = false, AFTER_DRAIN = false;
    bf16_t* P; const float* rc; const float* rs;
    __device__ __forceinline__ void operator()(const f32x4 (&acc)[2][2][4][2], const pg8::Unit& u, int wr, int wc, int fr, int fq) const {
        const int tb = u.pm % 65;
        const bool rope = (tb != 0) && (u.pn < 4);
#pragma unroll
        for (int ai = 0; ai < 2; ++ai)
#pragma unroll
            for (int m = 0; m < 4; ++m) {
                const int lr = ai * 128 + wr * 64 + m * 16 + fr;
                bf16_t* rowp = P + ((size_t)u.pm * 256 + lr) * NIN + u.pn * 256 + wc * 32 + 4 * fq;
                const int t = (tb - 1) * 256 + lr;
                const int pos = (wc & 1) ? (t & 63) : (t >> 6);
                f32x4 cv = (f32x4){1.f, 1.f, 1.f, 1.f}, sv = (f32x4){0.f, 0.f, 0.f, 0.f};
                if (rope) { cv = *(const f32x4*)(rc + pos * 16 + 4 * fq); sv = *(const f32x4*)(rs + pos * 16 + 4 * fq); }
#pragma unroll
                for (int bj = 0; bj < 2; ++bj) {
                    const f32x4 v0 = acc[ai][bj][m][0], v1 = acc[ai][bj][m][1];
                    f32x4 o0 = v0 * cv - v1 * sv, o1 = v1 * cv + v0 * sv;
                    if (u.pn < 2) { o0 = o0 * QSCALE; o1 = o1 * QSCALE; }
                    u32x2 w0, w1; w0.x = cvt_pk_bf16(o0[0], o0[1]); w0.y = cvt_pk_bf16(o0[2], o0[3]); w1.x = cvt_pk_bf16(o1[0], o1[1]); w1.y = cvt_pk_bf16(o1[2], o1[3]);
                    *(u32x2*)(rowp + bj * 128) = w0; *(u32x2*)(rowp + bj * 128 + 16) = w1;
                }
            }
    }
};
struct EpiRes {
    static constexpr bool PERM = false, AFTER_DRAIN = false;
    float* out; unsigned char* ws; int l; int goff;
    __device__ __forceinline__ void operator()(const f32x4 (&acc)[2][2][4][2], const pg8::Unit& u, int wr, int wc, int fr, int fq) const {
        const float* gv = modvec2(ws, l, u.pm * 256) + goff;
        const int col0 = u.pn * 256 + wc * 32 + 4 * fq;
        f32x4 g[2][2];
#pragma unroll
        for (int bj = 0; bj < 2; ++bj)
#pragma unroll
            for (int n = 0; n < 2; ++n) g[bj][n] = *(const f32x4*)(gv + col0 + bj * 128 + n * 16);
        float* xb = xrow2(out, ws, u.pm * 256);
#pragma unroll
        for (int ai = 0; ai < 2; ++ai)
#pragma unroll
            for (int m = 0; m < 4; ++m) {
                float* rp = xb + (size_t)(ai * 128 + wr * 64 + m * 16 + fr) * DM + col0;
#pragma unroll
                for (int bj = 0; bj < 2; ++bj)
#pragma unroll
                    for (int n = 0; n < 2; ++n) { f32x4* q = (f32x4*)(rp + bj * 128 + n * 16); const f32x4 xv = *q; *q = xv * DN_ALPHA + g[bj][n] * acc[ai][bj][m][n]; }
            }
    }
};
struct EpiUp {
    static constexpr bool PERM = false, AFTER_DRAIN = false;
    bf16_t* HID;
    __device__ __forceinline__ void operator()(const f32x4 (&acc)[2][2][4][2], const pg8::Unit& u, int wr, int wc, int fr, int fq) const {
#pragma unroll
        for (int ai = 0; ai < 2; ++ai)
#pragma unroll
            for (int m = 0; m < 4; ++m) {
                bf16_t* rowp = HID + ((size_t)u.pm * 256 + ai * 128 + wr * 64 + m * 16 + fr) * DFF + u.pn * 256 + wc * 32 + 4 * fq;
#pragma unroll
                for (int bj = 0; bj < 2; ++bj)
#pragma unroll
                    for (int n = 0; n < 2; ++n) { f32x4 v = acc[ai][bj][m][n];
                        v[0] = fmaxf(v[0], 0.f); v[1] = fmaxf(v[1], 0.f); v[2] = fmaxf(v[2], 0.f); v[3] = fmaxf(v[3], 0.f); v = v * v;
                        u32x2 w; w.x = cvt_pk_bf16(v[0], v[1]); w.y = cvt_pk_bf16(v[2], v[3]); *(u32x2*)(rowp + bj * 128 + n * 16) = w; }
            }
    }
};

struct XOrder {
    pg8::StaticOrder S;
    __device__ __forceinline__ void init(int N, int G, int c) { S.init(NBATCH * SEQ, N, G, c); }
    __device__ __forceinline__ bool next(int i, pg8::Unit& u) const { if (!S.next(i, u)) return false; u.pm += 1 + (u.pm >= 64 ? 1 : 0); return true; }
    __device__ __forceinline__ void a_ready(const pg8::Unit&) const {}
    __device__ __forceinline__ void done(const pg8::Unit&) const {}
};
template <class F>
__device__ __forceinline__ void ctx_gemm(const bf16_t* A, int lda, const bf16_t* Bt, int K, int nct, unsigned char* lds, const F& epi) {
    int tid_ = threadIdx.x; asm volatile("" : "+v"(tid_));
    const int lane = tid_ & 63, wid = __builtin_amdgcn_readfirstlane(tid_ >> 6), r = lane & 31, h = lane >> 5, kq = wid & 3, tp = wid >> 2;
    float* red = (float*)lds;
    const int ntile = 16 * nct, Kq = K >> 2;
    for (int t = blockIdx.x; 2 * t < ntile; t += gridDim.x) {
        const int T = 2 * t + tp, rt = T & 15, ct = T >> 4;
        const int row0 = (rt >> 3) * RPB + (rt & 7) * 32;
        const bf16_t* ap = A + (size_t)(row0 + r) * lda + kq * Kq + 8 * h;
        const bf16_t* bp = Bt + (size_t)(32 * ct + r) * K + kq * Kq + 8 * h;
        f32x16 acc = {};
#pragma unroll 8
        for (int k = 0; k < Kq; k += 16) { const bf16x8 a = *(const bf16x8*)(ap + k), b = *(const bf16x8*)(bp + k); acc = __builtin_amdgcn_mfma_f32_32x32x16_bf16(a, b, acc, 0, 0, 0); }
        if (kq != 0) {
#pragma unroll
            for (int reg = 0; reg < 16; ++reg) red[((tp * 4 + kq) * 16 + reg) * 64 + lane] = acc[reg];
        }
        __syncthreads();
        if (kq == 0) {
#pragma unroll
            for (int reg = 0; reg < 16; ++reg) acc[reg] += red[((tp * 4 + 1) * 16 + reg) * 64 + lane] + red[((tp * 4 + 2) * 16 + reg) * 64 + lane] + red[((tp * 4 + 3) * 16 + reg) * 64 + lane];
            epi(acc, row0, 32 * ct, r, h);
        }
        __syncthreads();
    }
}
struct CEpiIn { bf16_t* P;
    __device__ __forceinline__ void operator()(const f32x16& acc, int row0, int col0, int r, int h) const { const int col = col0 + r; const float sc = col < 512 ? QSCALE : 1.f;
#pragma unroll
        for (int reg = 0; reg < 16; ++reg) P[(size_t)(row0 + crow(reg, h)) * NIN + col] = f2bf(acc[reg] * sc); } };
struct CEpiRes { float* out; unsigned char* ws; int l; int goff;
    __device__ __forceinline__ void operator()(const f32x16& acc, int row0, int col0, int r, int h) const { const int col = col0 + r;
        const float g = ((const float*)(ws + WS_SMALL + SM_MOD))[(size_t)(l * 3 + 2) * 6144 + goff + col];
#pragma unroll
        for (int reg = 0; reg < 16; ++reg) { float* xp = xrow2(out, ws, row0 + crow(reg, h)) + col; *xp = *xp * DN_ALPHA + g * acc[reg]; } } };
struct CEpiUp { bf16_t* HID;
    __device__ __forceinline__ void operator()(const f32x16& acc, int row0, int col0, int r, int h) const { const int col = col0 + r;
#pragma unroll
        for (int reg = 0; reg < 16; ++reg) { const float v = fmaxf(acc[reg], 0.f); HID[(size_t)(row0 + crow(reg, h)) * DFF + col] = f2bf(v * v); } } };

namespace att {
constexpr int NW = 8, QBLK = 32, KVBLK = 64;
constexpr float SCALE = 0.125f, THR = 8.f;
constexpr int LDQ = NIN, LDK = NIN, LDO = DM;
constexpr int SHM_V = KVBLK * 128 * 2, SHM_K = KVBLK * 64 * 2, SHM_ATTN = 2 * SHM_V + 2 * SHM_K + NW * 64 * 4;
#define KSWZ(row, colB) ((row) * 128 + ((colB) ^ ((((row) >> 1) & 7) << 4)))
#define SBAR() __builtin_amdgcn_sched_barrier(0)
__device__ __forceinline__ unsigned cvtpk(float lo, float hi) { unsigned r; asm volatile("v_cvt_pk_bf16_f32 %0, %1, %2" : "=v"(r) : "v"(lo), "v"(hi)); return r; }
constexpr float THRL = THR * 1.4426950408889634f;
template <bool FIRST>
__device__ __forceinline__ void partialSM(f32x16& p0, f32x16& p1, float& m_reg, f32x16& negm, float& alpha) {
  float a = fmaxf(fmaxf(p0[0], p0[1]), p1[0]), b = fmaxf(fmaxf(p0[2], p0[3]), p1[1]); a = fmaxf(fmaxf(a, p1[2]), p1[3]);
#pragma unroll
  for (int r = 4; r < 16; r += 4) { a = fmaxf(fmaxf(a, p0[r]), p0[r + 1]); b = fmaxf(fmaxf(b, p0[r + 2]), p0[r + 3]); a = fmaxf(fmaxf(a, p1[r]), p1[r + 1]); b = fmaxf(fmaxf(b, p1[r + 2]), p1[r + 3]); }
  float pmax = fmaxf(a, b);
  { auto rr = __builtin_amdgcn_permlane32_swap(__float_as_uint(pmax), __float_as_uint(pmax), false, false);
    pmax = fmaxf(__uint_as_float(rr[0]), __uint_as_float(rr[1])); }
  if (!FIRST && __builtin_expect(__all(pmax <= THRL), 1)) { alpha = 1.f; }
  else { const float dl = FIRST ? pmax : fmaxf(pmax, 0.f); m_reg += dl; alpha = FIRST ? 1.f : __builtin_amdgcn_exp2f(-dl);
#pragma unroll
    for (int r = 0; r < 16; ++r) { p0[r] -= dl; p1[r] -= dl; }
    const float nm = -m_reg;
#pragma unroll
    for (int r = 0; r < 16; ++r) negm[r] = nm;
    asm volatile("" : "+v"(negm)); }
#pragma unroll
  for (int r = 0; r < 16; ++r) p0[r] = __builtin_amdgcn_exp2f(p0[r]);
}
__device__ __forceinline__ void finishSM(f32x16& p0, f32x16& p1, float alpha, float& l_reg, bf16x8& pa0, bf16x8& pa1, bf16x8& pa2, bf16x8& pa3) {
#pragma unroll
  for (int r = 0; r < 16; ++r) p1[r] = __builtin_amdgcn_exp2f(p1[r]);
  f32x2 s2 = (f32x2){p0[0], p0[1]};
#pragma unroll
  for (int r = 2; r < 16; r += 2) s2 += (f32x2){p0[r], p0[r + 1]};
#pragma unroll
  for (int r = 0; r < 16; r += 2) s2 += (f32x2){p1[r], p1[r + 1]};
  float ps = s2.x + s2.y;
  { auto rr = __builtin_amdgcn_permlane32_swap(__float_as_uint(ps), __float_as_uint(ps), false, false);
    ps = __uint_as_float(rr[0]) + __uint_as_float(rr[1]); }
  l_reg = l_reg * alpha + ps;
#define PK4(P, BASE, OUT) do { unsigned a0 = cvtpk(P[BASE + 0], P[BASE + 1]), a1 = cvtpk(P[BASE + 2], P[BASE + 3]);   \
    unsigned b0 = cvtpk(P[BASE + 4], P[BASE + 5]), b1 = cvtpk(P[BASE + 6], P[BASE + 7]);                              \
    auto r0 = __builtin_amdgcn_permlane32_swap(a0, b0, false, false); auto r1 = __builtin_amdgcn_permlane32_swap(a1, b1, false, false); \
    u32x4 w = {r0[0], r1[0], r0[1], r1[1]}; OUT = *reinterpret_cast<bf16x8*>(&w); } while (0)
  PK4(p0, 0, pa0); PK4(p0, 8, pa1); PK4(p1, 0, pa2); PK4(p1, 8, pa3);
#undef PK4
}
__device__ __forceinline__ void qkt(f32x16& p0, f32x16& p1, const char* Ks, const bf16x8* qr, const f32x16& negm, int r32, int hi) {
#pragma unroll
  for (int d0 = 0; d0 < 4; ++d0) { const int cb = (d0 * 16 + hi * 8) * 2;
    bf16x8 b0 = *reinterpret_cast<const bf16x8*>(Ks + KSWZ(r32, cb));
    bf16x8 b1 = *reinterpret_cast<const bf16x8*>(Ks + KSWZ(32 + r32, cb));
    if (d0 == 0) { p0 = __builtin_amdgcn_mfma_f32_32x32x16_bf16(b0, qr[0], negm, 0, 0, 0); p1 = __builtin_amdgcn_mfma_f32_32x32x16_bf16(b1, qr[0], negm, 0, 0, 0); }
    else { p0 = __builtin_amdgcn_mfma_f32_32x32x16_bf16(b0, qr[d0], p0, 0, 0, 0); p1 = __builtin_amdgcn_mfma_f32_32x32x16_bf16(b1, qr[d0], p1, 0, 0, 0); } }
}
__device__ __forceinline__ int v_st(int k, int c) { const int kk = (k & ~0xC) | ((k & 4) << 1) | ((k & 8) >> 1); return ((kk >> 3) * 4 + (c >> 5)) * 512 + ((kk & 7) * 32 + (c & 31)) * 2; }
__device__ __forceinline__ int v_rd_base(int lane) { return ((lane & 3) << 3) | (((lane >> 2) & 3) << 6) | (((lane >> 4) & 1) << 5) | (((lane >> 5) & 1) << 8); }
constexpr int v_rd_off(int d0, int ks, int half) { return d0 * 512 + ks * 4096 + half * 2048; }
template <int OFF> __device__ __forceinline__ s16x4 tr_read(int vb) {
  s16x4 r; asm volatile("ds_read_b64_tr_b16 %0, %1 offset:%2" : "=&v"(r) : "v"(vb), "i"(OFF) : "memory"); return r;
}
template <int D0> __device__ __forceinline__ void pv_one(f32x16& od, int vb, bf16x8 pa0, bf16x8 pa1, bf16x8 pa2, bf16x8 pa3) {
  const s16x4 l0 = tr_read<v_rd_off(D0, 0, 0)>(vb), h0 = tr_read<v_rd_off(D0, 0, 1)>(vb), l1 = tr_read<v_rd_off(D0, 1, 0)>(vb), h1 = tr_read<v_rd_off(D0, 1, 1)>(vb);
  const s16x4 l2 = tr_read<v_rd_off(D0, 2, 0)>(vb), h2 = tr_read<v_rd_off(D0, 2, 1)>(vb), l3 = tr_read<v_rd_off(D0, 3, 0)>(vb), h3 = tr_read<v_rd_off(D0, 3, 1)>(vb);
  asm volatile("s_waitcnt lgkmcnt(0)" ::: "memory"); SBAR();
#define PK(L, H) (bf16x8){L[0], L[1], L[2], L[3], H[0], H[1], H[2], H[3]}
  od = __builtin_amdgcn_mfma_f32_32x32x16_bf16(pa0, PK(l0, h0), od, 0, 0, 0);
  od = __builtin_amdgcn_mfma_f32_32x32x16_bf16(pa1, PK(l1, h1), od, 0, 0, 0);
  od = __builtin_amdgcn_mfma_f32_32x32x16_bf16(pa2, PK(l2, h2), od, 0, 0, 0);
  od = __builtin_amdgcn_mfma_f32_32x32x16_bf16(pa3, PK(l3, h3), od, 0, 0, 0);
#undef PK
}
__device__ __forceinline__ void pv_d0(f32x16* o, int vb, bf16x8 pa0, bf16x8 pa1, bf16x8 pa2, bf16x8 pa3) {
  pv_one<0>(o[0], vb, pa0, pa1, pa2, pa3); pv_one<1>(o[1], vb, pa0, pa1, pa2, pa3); pv_one<2>(o[2], vb, pa0, pa1, pa2, pa3); pv_one<3>(o[3], vb, pa0, pa1, pa2, pa3);
}
__device__ __forceinline__ void attn_unit(const bf16_t* Qb, const bf16_t* Kh, const bf16_t* Vh, bf16_t* Ob, int seq, char* lds) {
  int tid_ = threadIdx.x; asm volatile("" : "+v"(tid_));
  const int tid = tid_, wid = tid >> 6, lane = tid & 63, r32 = lane & 31, hi = lane >> 5;
  char* V_lds = lds; char* K_lds = lds + 2 * SHM_V;
  float* ws = (float*)(lds + 2 * SHM_V + 2 * SHM_K) + wid * 64; float* li_l = ws; float* al_l = ws + 32;
  float m_reg = 0.f, l_reg = 0; f32x16 o[4] = {}; bf16x8 qr[4]; f32x16 negm = f32x16{}; asm volatile("" : "+v"(negm));
  const bf16_t* Qw = Qb + (long)(wid * QBLK + r32) * LDQ + hi * 8;
#pragma unroll
  for (int d0 = 0; d0 < 4; ++d0) qr[d0] = *reinterpret_cast<const bf16x8*>(Qw + d0 * 16);
  const int sr = tid >> 4, sc = (tid & 15) * 8, vst0 = v_st(sr, sc), vst1 = v_st(32 + sr, sc);
  const int kr = tid >> 3, kc = (tid & 7) * 8, kst = KSWZ(kr, kc * 2);
  const int vb0 = (int)(uintptr_t)V_lds + v_rd_base(lane);
  struct { bf16x8 vs0, vs1, ks0; } sr_[2];
#define SLOAD(i, k0) do { sr_[i].vs0 = *reinterpret_cast<const bf16x8*>(&Vh[(long)((k0) + sr) * LDK + sc]); sr_[i].vs1 = *reinterpret_cast<const bf16x8*>(&Vh[(long)((k0) + 32 + sr) * LDK + sc]); \
    sr_[i].ks0 = *reinterpret_cast<const bf16x8*>(&Kh[(long)((k0) + kr) * LDK + kc]); } while (0)
#define SWRITE(b, i) do { *(bf16x8*)(V_lds + (b) * SHM_V + vst0) = sr_[i].vs0; *(bf16x8*)(V_lds + (b) * SHM_V + vst1) = sr_[i].vs1; \
    *(bf16x8*)(K_lds + (b) * SHM_K + kst) = sr_[i].ks0; } while (0)
#define SWAIT() asm volatile("s_waitcnt vmcnt(3)" ::: "memory")
#define RESC(a) do { if (__any((a) < 1.f)) { if (hi == 0) al_l[r32] = (a); asm volatile("s_waitcnt lgkmcnt(0)" ::: "memory"); \
    _Pragma("unroll") for (int d = 0; d < 4; ++d) _Pragma("unroll") for (int r = 0; r < 16; ++r) o[d][r] *= al_l[crow(r, hi)]; } } while (0)
  f32x16 pA0, pA1, pB0, pB1; float alA, alB; bf16x8 pa0, pa1, pa2, pa3; const int NT = seq / KVBLK;
  constexpr int SE = 0, SO = 1;
  SLOAD(SE, 0); asm volatile("s_waitcnt vmcnt(0)" ::: "memory"); SWRITE(0, SE); __syncthreads();
  qkt(pA0, pA1, K_lds, qr, negm, r32, hi); partialSM<true>(pA0, pA1, m_reg, negm, alA);
  SLOAD(SO, KVBLK); if (2 < NT) SLOAD(SE, 2 * KVBLK);
  SWAIT(); SWRITE(1, SO); __syncthreads();
  for (int j = 1; j + 1 < NT; j += 2) {
    SBAR(); qkt(pB0, pB1, K_lds + SHM_K, qr, negm, r32, hi);
    finishSM(pA0, pA1, alA, l_reg, pa0, pa1, pa2, pa3); SBAR();
    SLOAD(SO, (j + 2) * KVBLK); SBAR();
    pv_d0(o, vb0, pa0, pa1, pa2, pa3); partialSM<false>(pB0, pB1, m_reg, negm, alB);
    __syncthreads(); SWAIT(); SWRITE(0, SE);
    RESC(alB); __syncthreads();
    SBAR(); qkt(pA0, pA1, K_lds, qr, negm, r32, hi);
    finishSM(pB0, pB1, alB, l_reg, pa0, pa1, pa2, pa3); SBAR();
    if (j + 3 < NT) SLOAD(SE, (j + 3) * KVBLK); SBAR();
    pv_d0(o, vb0 + SHM_V, pa0, pa1, pa2, pa3); partialSM<false>(pA0, pA1, m_reg, negm, alA);
    __syncthreads(); SWAIT(); SWRITE(1, SO);
    RESC(alA); __syncthreads();
  }
  SBAR(); qkt(pB0, pB1, K_lds + SHM_K, qr, negm, r32, hi);
  finishSM(pA0, pA1, alA, l_reg, pa0, pa1, pa2, pa3); SBAR();
  pv_d0(o, vb0, pa0, pa1, pa2, pa3); partialSM<false>(pB0, pB1, m_reg, negm, alB);
  __syncthreads(); RESC(alB);
  finishSM(pB0, pB1, alB, l_reg, pa0, pa1, pa2, pa3); SBAR();
  pv_d0(o, vb0 + SHM_V, pa0, pa1, pa2, pa3);
  if (hi == 0) li_l[r32] = l_reg; asm volatile("s_waitcnt lgkmcnt(0)" ::: "memory");
  float rli[16];
#pragma unroll
  for (int r = 0; r < 16; ++r) rli[r] = __builtin_amdgcn_rcpf(li_l[crow(r, hi)]);
  bf16_t* Ow = Ob + (long)(wid * QBLK) * LDO;
#pragma unroll
  for (int r = 0; r < 16; ++r) { const int orow = crow(r, hi);
#pragma unroll
    for (int d0 = 0; d0 < 4; ++d0) Ow[(long)orow * LDO + d0 * 32 + r32] = f2bf(o[d0][r] * rli[r]); }
  __syncthreads();
#undef SLOAD
#undef SWRITE
#undef SWAIT
#undef RESC
}
#undef KSWZ
#undef SBAR
}

#define MFMA32(a, b, c) __builtin_amdgcn_mfma_f32_32x32x16_bf16(a, b, c, 0, 0, 0)
__device__ __forceinline__ bf16x8 ldB_strided(const bf16_t* p, size_t ldb) {
    bf16x8 b;
#pragma unroll
    for (int j = 0; j < 8; ++j) b[j] = (short)p[(size_t)j * ldb];
    return b;
}
__device__ __forceinline__ void four_stage0(const bf16_t* P, const bf16_t* W0T, bf16_t* Zr, bf16_t* Zi, int rt, int g, int lane) {
    const int r = lane & 31, h = lane >> 5;
    const bf16_t* Ap = P + (size_t)(32 * rt + r) * NIN + C_F + 64 * g + 8 * h;
    f32x16 acc[4] = {};
#pragma unroll
    for (int ks = 0; ks < 4; ++ks) { const bf16x8 a = *(const bf16x8*)(Ap + 16 * ks);
#pragma unroll
        for (int ct = 0; ct < 4; ++ct) { const bf16x8 b = *(const bf16x8*)(W0T + (32 * ct + r) * 64 + 16 * ks + 8 * h); acc[ct] = MFMA32(a, b, acc[ct]); } }
#pragma unroll
    for (int ct = 0; ct < 4; ++ct) { bf16_t* Zp = (ct < 2 ? Zr : Zi) + 64 * g + 32 * (ct & 1) + r;
#pragma unroll
        for (int reg = 0; reg < 16; ++reg) Zp[(size_t)(32 * rt + crow(reg, h)) * 256] = f2bf(acc[ct][reg]); }
}
__device__ __forceinline__ void four_stage1(const bf16_t* Zr, const bf16_t* Zi, const bf16_t* W1, const f32x2* tw, bf16_t* Ypr, bf16_t* Ypi, int b, int cb, int lane) {
    const int r = lane & 31, h = lane >> 5; const int n0 = 32 * cb, t2 = n0 >> 8, ch0 = n0 & 255;
    f32x16 acc[8] = {};
#pragma unroll
    for (int part = 0; part < 2; ++part) { const bf16_t* Zp = (part ? Zi : Zr) + (size_t)(b * RPB + CTXL + t2) * 256 + ch0 + r;
        for (int kk = 0; kk < 128; kk += 16) { const bf16x8 bf = ldB_strided(Zp + (size_t)(kk + 8 * h) * (128 * 256), (size_t)128 * 256);
#pragma unroll
            for (int mt = 0; mt < 8; ++mt) { const bf16x8 a = *(const bf16x8*)(W1 + (32 * mt + r) * 256 + part * 128 + kk + 8 * h); acc[mt] = MFMA32(a, bf, acc[mt]); } } }
#pragma unroll
    for (int mt = 0; mt < 4; ++mt)
#pragma unroll
        for (int reg = 0; reg < 16; ++reg) { const int k1 = 32 * mt + crow(reg, h); const f32x2 cs = tw[k1 * 128 + t2];
            const float yr = acc[mt][reg], yi = acc[mt + 4][reg]; const size_t o = ((size_t)(b * 128 + k1) * 128 + t2) * 256 + ch0 + r;
            Ypr[o] = f2bf(cs.x * yr + cs.y * yi); Ypi[o] = f2bf(cs.x * yi - cs.y * yr); }
}
__device__ __forceinline__ void four_stage2(const bf16_t* Ypr, const bf16_t* Ypi, const bf16_t* W2, bf16_t* MIX, int b, int k1, int cb, int lane) {
    const int r = lane & 31, h = lane >> 5;
    f32x16 acc[4] = {};
#pragma unroll
    for (int part = 0; part < 2; ++part) { const bf16_t* Yp = (part ? Ypi : Ypr) + ((size_t)(b * 128 + k1) * 128) * 256 + 32 * cb + r;
        for (int kk = 0; kk < 128; kk += 16) { const bf16x8 bf = ldB_strided(Yp + (size_t)(kk + 8 * h) * 256, 256);
#pragma unroll
            for (int mt = 0; mt < 4; ++mt) { const bf16x8 a = *(const bf16x8*)(W2 + (32 * mt + r) * 256 + part * 128 + kk + 8 * h); acc[mt] = MFMA32(a, bf, acc[mt]); } } }
#pragma unroll
    for (int mt = 0; mt < 4; ++mt)
#pragma unroll
        for (int reg = 0; reg < 16; ++reg) { const int k2 = 32 * mt + crow(reg, h);
            MIX[(size_t)(b * RPB + CTXL + k1 + 128 * k2) * DM + 768 + 32 * cb + r] = f2bf(acc[mt][reg]); }
}
__device__ __forceinline__ void four_ctx(const bf16_t* Zr, const bf16_t* Zi, const bf16_t* WC, bf16_t* MIX, int b, int cb, int lane) {
    const int r = lane & 31, h = lane >> 5;
    f32x16 acc[8] = {};
#pragma unroll
    for (int part = 0; part < 2; ++part) { const bf16_t* Zp = (part ? Zi : Zr) + (size_t)(b * RPB) * 256 + 32 * cb + r;
        for (int kk = 0; kk < 256; kk += 16) { const bf16x8 bf = ldB_strided(Zp + (size_t)(kk + 8 * h) * 256, 256);
#pragma unroll
            for (int mt = 0; mt < 8; ++mt) { const bf16x8 a = *(const bf16x8*)(WC + (32 * mt + r) * 512 + part * 256 + kk + 8 * h); acc[mt] = MFMA32(a, bf, acc[mt]); } } }
#pragma unroll
    for (int mt = 0; mt < 8; ++mt)
#pragma unroll
        for (int reg = 0; reg < 16; ++reg) { const int k = 32 * mt + crow(reg, h);
            MIX[(size_t)(b * RPB + k) * DM + 768 + 32 * cb + r] = f2bf(acc[mt][reg]); }
}

__device__ __forceinline__ void ln_mod_row(float* xr, const float* g, const float* bta, const float* sh, const float* sc, bf16_t* hrow, int lane, bool do_ln) {
    f32x4 v[4]; float s = 0.f;
#pragma unroll
    for (int j = 0; j < 4; ++j) { v[j] = *((const f32x4*)xr + lane + 64 * j); s += (v[j][0] + v[j][1]) + (v[j][2] + v[j][3]); }
    if (do_ln) {
        const float mean = wave_sum(s) * (1.f / DM); float s2 = 0.f;
#pragma unroll
        for (int j = 0; j < 4; ++j) { v[j] = v[j] - mean; s2 += (v[j][0] * v[j][0] + v[j][1] * v[j][1]) + (v[j][2] * v[j][2] + v[j][3] * v[j][3]); }
        const float rstd = 1.f / sqrtf(wave_sum(s2) * (1.f / DM) + LN_EPS);
#pragma unroll
        for (int j = 0; j < 4; ++j) { const f32x4 gg = *((const f32x4*)g + lane + 64 * j), bb = *((const f32x4*)bta + lane + 64 * j); v[j] = v[j] * rstd * gg + bb; }
    }
#pragma unroll
    for (int j = 0; j < 4; ++j) *((f32x4*)xr + lane + 64 * j) = v[j];
    if (sh) {
#pragma unroll
        for (int j = 0; j < 4; ++j) { const f32x4 a = *((const f32x4*)sh + lane + 64 * j), c = *((const f32x4*)sc + lane + 64 * j); const f32x4 y = v[j] * (c + 1.0f) + a;
            u32x2 w; w.x = cvt_pk_bf16(y[0], y[1]); w.y = cvt_pk_bf16(y[2], y[3]); *((u32x2*)hrow + lane + 64 * j) = w; }
    }
}
__device__ __forceinline__ void conv_row(const bf16_t* P, const float* cw, const float* cbias, bf16_t* MIX, int m, int lane) {
    const int j = m % RPB; const bool hp = !(j == 0 || j == CTXL), hn = !(j == CTXL - 1 || j == RPB - 1);
    const bf16_t* pr = P + (size_t)m * NIN + 4 * lane;
    const u32x2 u1 = *(const u32x2*)(pr + C_U), c1 = *(const u32x2*)(pr + C_GC), gb = *(const u32x2*)(pr + C_GB);
    u32x2 u0 = (u32x2){0u, 0u}, c0 = u0, u2 = u0, c2 = u0;
    if (hp) { u0 = *(const u32x2*)(pr - NIN + C_U); c0 = *(const u32x2*)(pr - NIN + C_GC); }
    if (hn) { u2 = *(const u32x2*)(pr + NIN + C_U); c2 = *(const u32x2*)(pr + NIN + C_GC); }
    const f32x4 w0 = *(const f32x4*)(cw + 4 * lane), w1 = *(const f32x4*)(cw + 256 + 4 * lane), w2 = *(const f32x4*)(cw + 512 + 4 * lane), bb = *(const f32x4*)(cbias + 4 * lane);
    const f32x4 z0 = (f32x4){bflo(u0.x) * bflo(c0.x), bfhi(u0.x) * bfhi(c0.x), bflo(u0.y) * bflo(c0.y), bfhi(u0.y) * bfhi(c0.y)};
    const f32x4 z1 = (f32x4){bflo(u1.x) * bflo(c1.x), bfhi(u1.x) * bfhi(c1.x), bflo(u1.y) * bflo(c1.y), bfhi(u1.y) * bfhi(c1.y)};
    const f32x4 z2 = (f32x4){bflo(u2.x) * bflo(c2.x), bfhi(u2.x) * bfhi(c2.x), bflo(u2.y) * bflo(c2.y), bfhi(u2.y) * bfhi(c2.y)};
    const f32x4 gbf = (f32x4){bflo(gb.x), bfhi(gb.x), bflo(gb.y), bfhi(gb.y)};
    const f32x4 y = gbf * (w0 * z0 + w1 * z1 + w2 * z2 + bb);
    u32x2 w; w.x = cvt_pk_bf16(y[0], y[1]); w.y = cvt_pk_bf16(y[2], y[3]);
    *(u32x2*)(MIX + (size_t)m * DM + 512 + 4 * lane) = w;
}
__device__ __forceinline__ void combine_row(const bf16_t* OATT, const float* subw, float lam, float one_m_li, bf16_t* MIX, int m, int lane) {
    const int h = lane >> 4, li = lane & 15;
    const bf16_t* op = OATT + (size_t)m * DM + h * 256 + 8 * li;
    const u32x4 a = *(const u32x4*)op, b = *(const u32x4*)(op + 128);
    float o[8];
    o[0] = bflo(a.x) - lam * bflo(b.x); o[1] = bfhi(a.x) - lam * bfhi(b.x); o[2] = bflo(a.y) - lam * bflo(b.y); o[3] = bfhi(a.y) - lam * bfhi(b.y);
    o[4] = bflo(a.z) - lam * bflo(b.z); o[5] = bfhi(a.z) - lam * bfhi(b.z); o[6] = bflo(a.w) - lam * bflo(b.w); o[7] = bfhi(a.w) - lam * bfhi(b.w);
    float ss = 0.f;
#pragma unroll
    for (int i = 0; i < 8; ++i) ss += o[i] * o[i];
    ss += __shfl_xor(ss, 1); ss += __shfl_xor(ss, 2); ss += __shfl_xor(ss, 4); ss += __shfl_xor(ss, 8);
    const float rs = (1.f / sqrtf(ss * (1.f / 128.f) + RMS_EPS)) * one_m_li;
    const f32x4 w0 = *(const f32x4*)(subw + 8 * li), w1 = *(const f32x4*)(subw + 8 * li + 4);
    u32x4 w; w.x = cvt_pk_bf16(o[0] * rs * w0[0], o[1] * rs * w0[1]); w.y = cvt_pk_bf16(o[2] * rs * w0[2], o[3] * rs * w0[3]);
    w.z = cvt_pk_bf16(o[4] * rs * w1[0], o[5] * rs * w1[1]); w.w = cvt_pk_bf16(o[6] * rs * w1[2], o[7] * rs * w1[3]);
    *(u32x4*)(MIX + (size_t)m * DM + h * 128 + 8 * li) = w;
}

__device__ __forceinline__ void transpose_item(const float* W, int K, int N, bf16_t* WT, float* scr, int item, int lane) {
    const int nblk = N / 32, kb = item / nblk, nb = item % nblk, k0 = 64 * kb, n0 = 32 * nb;
#pragma unroll 8
    for (int i = 0; i < 32; ++i) { const int kk = 2 * i + (lane >> 5); scr[kk * 33 + (lane & 31)] = W[(size_t)(k0 + kk) * N + n0 + (lane & 31)]; }
    asm volatile("s_waitcnt lgkmcnt(0)" ::: "memory");
    const int c = lane & 7;
#pragma unroll
    for (int j = 0; j < 4; ++j) { const int n = (lane >> 3) + 8 * j; const float* s = scr + (8 * c) * 33 + n;
        u32x4 o; o.x = cvt_pk_bf16(s[0 * 33], s[1 * 33]); o.y = cvt_pk_bf16(s[2 * 33], s[3 * 33]); o.z = cvt_pk_bf16(s[4 * 33], s[5 * 33]); o.w = cvt_pk_bf16(s[6 * 33], s[7 * 33]);
        *(u32x4*)(WT + (size_t)(n0 + n) * K + k0 + 8 * c) = o; }
    asm volatile("s_waitcnt lgkmcnt(0)" ::: "memory");
}
__device__ __forceinline__ float siluf(float x) { return x / (1.f + expf(-x)); }

constexpr int LDS_BYTES = 131072 + 1024;
constexpr int REP_ATT = 1, REP_MIXB = 1, REP_CD = 1;
__global__ void __launch_bounds__(512, 2) mega_fwd(Params p) {
    extern __shared__ __attribute__((aligned(16))) unsigned char lds[];
    cg::grid_group grid = cg::this_grid();
    const int tid = threadIdx.x, lane = tid & 63, wid = __builtin_amdgcn_readfirstlane(tid >> 6);
    const int G = gridDim.x, gw = blockIdx.x * 8 + wid, NGW = G * 8;
    unsigned char* ws = p.ws;
    bf16_t* Wt_in = (bf16_t*)(ws + WS_WIN); bf16_t* Wt_out = (bf16_t*)(ws + WS_WOUT); bf16_t* Wt_up = (bf16_t*)(ws + WS_WUP); bf16_t* Wt_dn = (bf16_t*)(ws + WS_WDN);
    float* modv = (float*)(ws + WS_SMALL + SM_MOD); float* ropec = (float*)(ws + WS_SMALL + SM_ROPEC); float* ropes = (float*)(ws + WS_SMALL + SM_ROPES);
    bf16_t* W0T = (bf16_t*)(ws + WS_SMALL + SM_W0T); bf16_t* W1 = (bf16_t*)(ws + WS_SMALL + SM_W1); bf16_t* W2 = (bf16_t*)(ws + WS_SMALL + SM_W2); bf16_t* WC = (bf16_t*)(ws + WS_SMALL + SM_WC);
    f32x2* tw = (f32x2*)(ws + WS_SMALL + SM_TW);
    bf16_t* H = (bf16_t*)(ws + WS_H); bf16_t* MIX = (bf16_t*)(ws + WS_MIX);
    bf16_t* Pb = (bf16_t*)(ws + WS_R + R_P); bf16_t* OATT = (bf16_t*)(ws + WS_R + R_OATT); bf16_t* Zr = (bf16_t*)(ws + WS_R + R_ZR); bf16_t* Zi = (bf16_t*)(ws + WS_R + R_ZI);
    bf16_t* HID = (bf16_t*)(ws + WS_R);
    bf16_t* Ypr = (bf16_t*)(ws + WS_H); bf16_t* Ypi = (bf16_t*)(ws + WS_H + YP_PLANE);
    __attribute__((address_space(3))) unsigned char* lds3 = (__attribute__((address_space(3))) unsigned char*)lds;

    {
        float* scr = (float*)(lds + wid * 16384);
        constexpr int I_IN = (DM / 64) * (NIN / 32), I_OUT = (DM / 64) * (DM / 32), I_UP = (DM / 64) * (DFF / 32), I_DN = (DFF / 64) * (DM / 32), I_L = I_IN + I_OUT + I_UP + I_DN;
        for (int it = gw; it < DEPTH * I_L; it += NGW) {
            const int l = it / I_L; int r = it - l * I_L;
            if (r < I_IN) { transpose_item(p.w_in + (size_t)l * DM * NIN, DM, NIN, Wt_in + (size_t)l * NIN * DM, scr, r, lane); continue; } r -= I_IN;
            if (r < I_OUT) { transpose_item(p.w_out + (size_t)l * DM * DM, DM, DM, Wt_out + (size_t)l * DM * DM, scr, r, lane); continue; } r -= I_OUT;
            if (r < I_UP) { transpose_item(p.w_up + (size_t)l * DM * DFF, DM, DFF, Wt_up + (size_t)l * DFF * DM, scr, r, lane); continue; } r -= I_UP;
            transpose_item(p.w_down + (size_t)l * DFF * DM, DFF, DM, Wt_dn + (size_t)l * DM * DFF, scr, r, lane);
        }
        __syncthreads();
        float* sv = (float*)lds; float* red = (float*)(lds + 12288);
        for (int i = tid; i < 3 * DM; i += 512) { const int s = i >> 10, k = i & 1023; sv[i] = siluf(s < 2 ? p.c[s * DM + k] : p.c_ctx[k]); }
        __syncthreads();
        for (int task = blockIdx.x; task < DEPTH * 96; task += G) {
            const int l = task / 96, n = (task % 96) * 64 + lane;
            const float* wp = p.w_mod + (size_t)l * DM * 6144 + n;
            float a0 = 0.f, a1 = 0.f, a2 = 0.f;
#pragma unroll 8
            for (int k = wid * 128; k < wid * 128 + 128; ++k) { const float wv = wp[(size_t)k * 6144]; a0 += sv[k] * wv; a1 += sv[DM + k] * wv; a2 += sv[2 * DM + k] * wv; }
            red[(wid * 3 + 0) * 64 + lane] = a0; red[(wid * 3 + 1) * 64 + lane] = a1; red[(wid * 3 + 2) * 64 + lane] = a2;
            __syncthreads();
            if (wid < 3) { float s = p.b_mod[l * 6144 + n];
#pragma unroll
                for (int w = 0; w < 8; ++w) s += red[(w * 3 + wid) * 64 + lane];
                modv[(size_t)(l * 3 + wid) * 6144 + n] = s; }
            __syncthreads();
        }
        const int gt = blockIdx.x * 512 + tid, NGT = G * 512;
        for (int i = gt; i < 256 * 16; i += NGT) { const int pos = i >> 4, fi = i & 15; double invf = 1.0; for (int q = 0; q < fi; ++q) invf *= 0.5623413251903491;
            const double rev = (double)pos * invf * 0.15915494309189535; const float fr = (float)(rev - floor(rev));
            ropec[i] = __builtin_amdgcn_cosf(fr); ropes[i] = __builtin_amdgcn_sinf(fr); }
        for (int i = gt; i < 128 * 64; i += NGT) { const int n = i >> 6, c = i & 63; const int m = n & 63; const float fr = (float)((m * c) & 63) * (1.f / 64.f);
            W0T[i] = f2bf((n < 64 ? __builtin_amdgcn_cosf(fr) : -__builtin_amdgcn_sinf(fr)) * 0.125f); }
        for (int i = gt; i < 256 * 256; i += NGT) { const int row = i >> 8, col = i & 255; const int k1 = row & 127, t1 = col & 127, po = row >> 7, pi = col >> 7;
            const float fr = (float)((k1 * t1) & 127) * (1.f / 128.f); const float c = __builtin_amdgcn_cosf(fr), s = __builtin_amdgcn_sinf(fr);
            const float v = po == 0 ? (pi == 0 ? c : s) : (pi == 0 ? -s : c); W1[i] = f2bf(v * 0.08838834764831845f); }
        for (int i = gt; i < 128 * 256; i += NGT) { const int k2 = i >> 8, col = i & 255; const int t2 = col & 127, pi = col >> 7;
            const float fr = (float)((k2 * t2) & 127) * (1.f / 128.f); W2[i] = f2bf((pi == 0 ? __builtin_amdgcn_cosf(fr) : __builtin_amdgcn_sinf(fr)) * 0.08838834764831845f); }
        for (int i = gt; i < 256 * 512; i += NGT) { const int k = i >> 9, col = i & 511; const int t = col & 255, pi = col >> 8;
            const float fr = (float)((k * t) & 255) * (1.f / 256.f); WC[i] = f2bf((pi == 0 ? __builtin_amdgcn_cosf(fr) : __builtin_amdgcn_sinf(fr)) * 0.0625f); }
        for (int i = gt; i < 128 * 128; i += NGT) { const int k1 = i >> 7, t2 = i & 127; const float fr = (float)(k1 * t2) * (1.f / 16384.f);
            tw[i] = (f32x2){__builtin_amdgcn_cosf(fr), __builtin_amdgcn_sinf(fr)}; }
    }
    grid.sync();
    for (int m = gw; m < MROWS; m += NGW) {
        const int b = m / RPB, j = m - b * RPB;
        const float* src = j < CTXL ? p.ctx + (size_t)(b * CTXL + j) * DM : p.x + ((size_t)b * SEQ + (j - CTXL)) * DM;
        float* xr = xrow(p, m); const float* mv = modvec(p, 0, m);
        f32x4 v[4];
#pragma unroll
        for (int q = 0; q < 4; ++q) v[q] = *((const f32x4*)src + lane + 64 * q);
#pragma unroll
        for (int q = 0; q < 4; ++q) { *((f32x4*)xr + lane + 64 * q) = v[q];
            const f32x4 a = *((const f32x4*)mv + lane + 64 * q), c = *((const f32x4*)(mv + DM) + lane + 64 * q); const f32x4 y = v[q] * (c + 1.0f) + a;
            u32x2 w; w.x = cvt_pk_bf16(y[0], y[1]); w.y = cvt_pk_bf16(y[2], y[3]); *((u32x2*)(H + (size_t)m * DM) + lane + 64 * q) = w; }
    }
    grid.sync();

#define PHASE_IDS() int tid_ = threadIdx.x; asm volatile("" : "+v"(tid_)); const int lane = tid_ & 63, wid = __builtin_amdgcn_readfirstlane(tid_ >> 6); const int gw = blockIdx.x * 8 + wid; (void)lane; (void)gw
#pragma nounroll
    for (int l = 0; l < DEPTH; ++l) {
        { pg8::Gemm g{H, Wt_in + (size_t)l * NIN * DM, MROWS, NIN, DM}; XOrder S; S.init(NIN, G, (int)blockIdx.x);
          EpiIn E{Pb, ropec, ropes};
          pg8::gemm_phase<EpiIn, XOrder, true, true>(lds3, g, S, E);
          ctx_gemm(H, DM, Wt_in + (size_t)l * NIN * DM, DM, NIN / 32, lds, CEpiIn{Pb}); }
        grid.sync();
        {
            PHASE_IDS();
            for (int rep = 0; rep < REP_ATT; ++rep)
            for (int uidx = blockIdx.x; uidx < 1024 + 16; uidx += G) {
                int b, h, pm_, qrow0, seq;
                if (uidx < 1024) { const int w = uidx & 255, i = uidx >> 8; const int xg = w & 7, li = w >> 3; b = xg >> 2; h = xg & 3; pm_ = i >> 1; const int qb = (i & 1) * 32 + li;
                    qrow0 = b * RPB + CTXL + qb * 256; seq = RPB; }
                else { const int c = uidx - 1024; b = c >> 3; h = (c >> 1) & 3; pm_ = c & 1; qrow0 = b * RPB; seq = CTXL; }
                const size_t krow0 = (size_t)b * RPB;
                att::attn_unit(Pb + (size_t)qrow0 * NIN + C_Q + h * 128 + pm_ * 64, Pb + krow0 * NIN + C_K + h * 128 + pm_ * 64, Pb + krow0 * NIN + C_V + h * 128,
                               OATT + (size_t)qrow0 * DM + h * 256 + pm_ * 128, seq, (char*)lds);
            }
            const float* cw = p.conv_w + (size_t)l * 3 * 256; const float* cbv = p.conv_b + (size_t)l * 256;
            for (int rep = 0; rep < REP_MIXB; ++rep) {
            for (int m = gw; m < MROWS; m += NGW) conv_row(Pb, cw, cbv, MIX, m, lane);
            for (int t = gw; t < (MROWS / 32) * 4; t += NGW) four_stage0(Pb, W0T, Zr, Zi, t >> 2, t & 3, lane); }
        }
        grid.sync();
        for (int rep = 0; rep < REP_CD; ++rep) {
        {
            PHASE_IDS();
            for (int t = gw; t < NBATCH * 1024; t += NGW) four_stage1(Zr, Zi, W1, tw, Ypr, Ypi, t >> 10, t & 1023, lane);
            for (int t = gw; t < NBATCH * 8; t += NGW) four_ctx(Zr, Zi, WC, MIX, t >> 3, t & 7, lane);
            const float* lp = p.diff_lambda + (size_t)l * 256;
            const float s1 = wave_sum(lp[lane] * lp[64 + lane]), s2 = wave_sum(lp[128 + lane] * lp[192 + lane]);
            const float lam_init = 0.8f - 0.6f * expf(-0.3f * (float)l);
            const float lam = expf(s1) - expf(s2) + lam_init;
            const float* subw = p.subln_w + (size_t)l * 128;
            for (int m = gw; m < MROWS; m += NGW) combine_row(OATT, subw, lam, 1.f - lam_init, MIX, m, lane);
        }
        grid.sync();
        { PHASE_IDS(); for (int t = gw; t < NBATCH * 128 * 8; t += NGW) four_stage2(Ypr, Ypi, W2, MIX, t >> 10, (t >> 3) & 127, t & 7, lane); }
        grid.sync();
        }
        { pg8::Gemm g{MIX, Wt_out + (size_t)l * DM * DM, MROWS, DM, DM}; XOrder S; S.init(DM, G, (int)blockIdx.x);
          EpiRes E{p.out, p.ws, l, 2048};
          pg8::gemm_phase<EpiRes, XOrder, true, true>(lds3, g, S, E);
          if (l + 1 < DEPTH) ctx_gemm(MIX, DM, Wt_out + (size_t)l * DM * DM, DM, DM / 32, lds, CEpiRes{p.out, p.ws, l, 2048}); }
        grid.sync();
        { PHASE_IDS(); for (int m = gw; m < MROWS; m += NGW) { const float* mv = modvec(p, l, m);
            ln_mod_row(xrow(p, m), p.ln1_g + (size_t)l * DM, p.ln1_b + (size_t)l * DM, mv + 3072, mv + 4096, H + (size_t)m * DM, lane, true); } }
        grid.sync();
        { pg8::Gemm g{H, Wt_up + (size_t)l * DFF * DM, MROWS, DFF, DM}; XOrder S; S.init(DFF, G, (int)blockIdx.x);
          EpiUp E{HID};
          pg8::gemm_phase<EpiUp, XOrder, true, true>(lds3, g, S, E);
          if (l + 1 < DEPTH) ctx_gemm(H, DM, Wt_up + (size_t)l * DFF * DM, DM, DFF / 32, lds, CEpiUp{HID}); }
        grid.sync();
        { pg8::Gemm g{HID, Wt_dn + (size_t)l * DM * DFF, MROWS, DM, DFF}; XOrder S; S.init(DM, G, (int)blockIdx.x);
          EpiRes E{p.out, p.ws, l, 5120};
          pg8::gemm_phase<EpiRes, XOrder, true, true>(lds3, g, S, E);
          if (l + 1 < DEPTH) ctx_gemm(HID, DFF, Wt_dn + (size_t)l * DM * DFF, DFF, DM / 32, lds, CEpiRes{p.out, p.ws, l, 5120}); }
        grid.sync();
        { PHASE_IDS(); for (int m = gw; m < MROWS; m += NGW) { const bool more = (l + 1 < DEPTH); const float* mv = modvec(p, more ? l + 1 : l, m);
            ln_mod_row(xrow(p, m), p.ln2_g + (size_t)l * DM, p.ln2_b + (size_t)l * DM, more ? mv : nullptr, mv + DM, H + (size_t)m * DM, lane, true); } }
        if (l + 1 < DEPTH) grid.sync();
    }
}

extern "C" void kernel_launch(void* const* d_in, const int* in_sizes, int n_in, void* d_out, int out_size, void* d_ws, size_t ws_size, hipStream_t stream) {
    static int grid = 0;
    if (grid == 0) {
        if (n_in != 18 || out_size != NBATCH * SEQ * DM || ws_size < WS_END) { fprintf(stderr, "kernel_launch: unexpected shapes (n_in %d out %d ws %zu)\n", n_in, out_size, ws_size); grid = -1; return; }
        int dev = 0, cus = 0, per_cu = 0;
        hipGetDevice(&dev); hipDeviceGetAttribute(&cus, hipDeviceAttributeMultiprocessorCount, dev);
        if (hipFuncSetAttribute((const void*)mega_fwd, hipFuncAttributeMaxDynamicSharedMemorySize, LDS_BYTES) != hipSuccess) { fprintf(stderr, "kernel_launch: hipFuncSetAttribute failed\n"); grid = -1; return; }
        hipOccupancyMaxActiveBlocksPerMultiprocessor(&per_cu, (const void*)mega_fwd, 512, LDS_BYTES);
        (void)hipGetLastError();
        if (per_cu < 1) per_cu = 1;
        grid = cus;
        if (grid <= 0) grid = 256;
    }
    if (grid < 0) return;
    Params p{};
    const float** f = (const float**)&p;
    for (int i = 0; i < 18; ++i) f[i] = (const float*)d_in[i];
    p.out = (float*)d_out; p.ws = (unsigned char*)d_ws;
    void* args[] = {&p};
    hipError_t e = hipLaunchCooperativeKernel((const void*)mega_fwd, dim3(grid), dim3(512), args, LDS_BYTES, stream);
    if (e != hipSuccess) fprintf(stderr, "cooperative launch failed: %s (grid %d)\n", hipGetErrorString(e), grid);
}
```

```cpp
#include <hip/hip_runtime.h>
#include <hip/hip_cooperative_groups.h>
#include <cstdio>
#include <cstdint>
namespace cg = cooperative_groups;

constexpr int DM = 1024, NBATCH = 2, SEQ = 16384, DEPTH = 4, CTXL = 256;
constexpr int RPB = CTXL + SEQ;
constexpr int MROWS = NBATCH * RPB;
constexpr int NIN = 2560, DFF = 4096;
constexpr int C_Q = 0, C_K = 512, C_V = 1024, C_U = 1536, C_GB = 1792, C_GC = 2048, C_F = 2304;
constexpr float LN_EPS = 1e-5f, RMS_EPS = 1e-5f;
constexpr float DN_ALPHA = 1.681792830507429f;

constexpr size_t WS_WIN = 0;
constexpr size_t WS_WOUT = WS_WIN + (size_t)DEPTH * NIN * DM * 2;
constexpr size_t WS_WUP = WS_WOUT + (size_t)DEPTH * DM * DM * 2;
constexpr size_t WS_WDN = WS_WUP + (size_t)DEPTH * DFF * DM * 2;
constexpr size_t WS_SMALL = WS_WDN + (size_t)DEPTH * DM * DFF * 2;
constexpr size_t SM_MOD = 0;
constexpr size_t SM_ROPEC = SM_MOD + (size_t)DEPTH * 3 * 6144 * 4;
constexpr size_t SM_ROPES = SM_ROPEC + 256 * 16 * 4;
constexpr size_t SM_W0T = SM_ROPES + 256 * 16 * 4;
constexpr size_t SM_W1 = SM_W0T + 128 * 64 * 2;
constexpr size_t SM_W2 = SM_W1 + 256 * 256 * 2;
constexpr size_t SM_WC = SM_W2 + 128 * 256 * 2;
constexpr size_t SM_TW = SM_WC + 256 * 512 * 2;
constexpr size_t SM_END = SM_TW + 128 * 128 * 8;
static_assert(SM_END <= (2u << 20), "small region");
constexpr size_t WS_XC = WS_SMALL + (2u << 20);
constexpr size_t WS_H = WS_XC + (size_t)NBATCH * CTXL * DM * 4;
constexpr size_t WS_MIX = WS_H + (size_t)MROWS * DM * 2;
constexpr size_t WS_R = WS_MIX + (size_t)MROWS * DM * 2;
constexpr size_t R_P = 0, R_OATT = (size_t)MROWS * NIN * 2, R_ZR = R_OATT + (size_t)MROWS * DM * 2, R_ZI = R_ZR + (size_t)MROWS * 256 * 2;
static_assert(R_ZI + (size_t)MROWS * 256 * 2 <= (size_t)MROWS * DFF * 2, "overlay");
constexpr size_t WS_END = WS_R + (size_t)MROWS * DFF * 2;
constexpr size_t WS_CTL = WS_END;
constexpr size_t CTL_BYTES = 65536;
static_assert(WS_CTL + CTL_BYTES <= 536870912ull, "workspace");
constexpr size_t YP_PLANE = (size_t)NBATCH * 128 * 128 * 256 * 2;
static_assert(2 * YP_PLANE <= (size_t)MROWS * DM * 2, "Y' planes inside H");

struct Params {
    const float *x, *c, *ctx, *c_ctx, *w_mod, *b_mod, *w_in, *diff_lambda, *subln_w, *conv_w, *conv_b, *w_out, *ln1_g, *ln1_b, *w_up, *w_down, *ln2_g, *ln2_b;
    float* out; unsigned char* ws;
};

__device__ __forceinline__ int mk_tid(int wid_s) { int l; asm volatile("v_mbcnt_lo_u32_b32 %0, -1, 0\n\tv_mbcnt_hi_u32_b32 %0, -1, %0" : "=v"(l)); return wid_s * 64 + l; }

namespace pg8 {
#define PG8_LAS __attribute__((address_space(3)))
typedef unsigned short bf16_t;
typedef short bf16x8 __attribute__((ext_vector_type(8)));
typedef float f32x4 __attribute__((ext_vector_type(4)));
typedef unsigned u32x4 __attribute__((ext_vector_type(4)));
constexpr int BM = 256, BK = 64, HALF = 128, HTB = HALF * BK * 2  , STAGE_BYTES = 8 * HTB, NXCD = 8, WGM = 8;

__host__ __device__ __forceinline__ int lds_byte(int r, int c) { const int st = (r >> 4) * 2 + (c >> 5), rr = r & 15, cc = c & 31, ob = rr * 64 + cc * 2; return st * 1024 + (ob ^ (((ob >> 9) & 1) << 5)); }
__host__ __device__ __forceinline__ void stage_rc(int b, int& R, int& C) { const int st = b / 1024, sb = b % 1024, swz = sb ^ (((sb >> 9) & 1) << 5); R = (st >> 1) * 16 + swz / 64; C = (st & 1) * 32 + (swz % 64) / 2; }
__host__ __device__ __forceinline__ int perm32(int rho) { const int n = rho >> 4, i = rho & 15; return 8 * (i >> 2) + 4 * n + (i & 3); }

struct Unit { int pm, pn; };
struct Gemm { const bf16_t* A; const bf16_t* Bt; int M, N, K; };

struct StaticOrder {
    int nM, nN, nwg, G, c;
    __host__ __device__ void init(int M, int N, int G_, int c_) { nM = M / BM; nN = N / BM; nwg = nM * nN; G = G_; c = c_; }
    __host__ __device__ bool next(int i, Unit& u) const {
        const long L = (long)i * G + c; if (L >= nwg) return false;
        int wgid = (int)L; { const int q = nwg / NXCD, r = nwg % NXCD, xcd = wgid % NXCD, off = wgid / NXCD; wgid = (xcd < r ? xcd * (q + 1) : r * (q + 1) + (xcd - r) * q) + off; }
        const int nig = WGM * nN, gid = wgid / nig, fm = gid * WGM, gsz = (nM - fm) < WGM ? (nM - fm) : WGM;
        u.pm = fm + ((wgid % nig) % gsz); u.pn = (wgid % nig) / gsz; return true;
    }
    __device__ __forceinline__ void a_ready(const Unit&) const {}
    __device__ __forceinline__ void done(const Unit&) const {}
};

__device__ __forceinline__ unsigned cvt_pk_bf16(float lo, float hi) { unsigned r; asm volatile("v_cvt_pk_bf16_f32 %0, %1, %2" : "=v"(r) : "v"(lo), "v"(hi)); return r; }
typedef float f32x2 __attribute__((ext_vector_type(2)));
template <class Epi, class Sched, bool ALIGN_EPI = false, bool SP2 = false>
__device__ __forceinline__ void gemm_phase(PG8_LAS unsigned char* lds, const Gemm g, const Sched& S, const Epi& E, const int wid_s) {
    const int tid_ = mk_tid(wid_s);
    const int tid = tid_, wid = __builtin_amdgcn_readfirstlane(tid >> 6), lane = tid & 63, wr = wid >> 2, wc = wid & 3, fr = lane & 15, fq = lane >> 4;
    const int K = g.K, nt = K / BK;
    unsigned voffA[2], voffB[2];
#pragma unroll
    for (int i = 0; i < 2; ++i) { int R, C; stage_rc(tid * 16 + i * 8192, R, C); const int Rb = Epi::PERM ? ((R & ~31) + perm32(R & 31)) : R;
        voffA[i] = (unsigned)(R * K + C) * 2u; voffB[i] = (unsigned)(Rb * K + C) * 2u; }
    const size_t kstep = (size_t)(BK * 2);
    const size_t hstep = (size_t)HALF * K * 2;
    const size_t tstep = 2 * hstep;
    const unsigned ldsw = (unsigned)wid * 1024u;
    const int aoff = lds_byte(wr * 64 + fr, fq * 8), boff = lds_byte(wc * 32 + fr, fq * 8);
#define PG8_SA(b, h) (((b) * 2 + (h)) * HTB)
#define PG8_SB(b, h) ((4 + (b) * 2 + (h)) * HTB)
#define PG8_STAGE(bufoff, gbase, voff) do { _Pragma("unroll") for (int _i = 0; _i < 2; ++_i) \
        __builtin_amdgcn_global_load_lds((const unsigned*)((const char*)(gbase) + (voff)[_i]), (PG8_LAS unsigned*)(lds + (bufoff) + ldsw + _i * 8192), 16, 0, 0); } while (0)
#define PG8_LDA(dst, b, h) do { _Pragma("unroll") for (int m = 0; m < 4; ++m) _Pragma("unroll") for (int k = 0; k < 2; ++k) dst[m][k] = *(const PG8_LAS bf16x8*)(lds + PG8_SA(b, h) + aoff + m * 2048 + k * 1024); } while (0)
#define PG8_LDB(dst, b, h) do { _Pragma("unroll") for (int n = 0; n < 2; ++n) _Pragma("unroll") for (int k = 0; k < 2; ++k) dst[n][k] = *(const PG8_LAS bf16x8*)(lds + PG8_SB(b, h) + boff + n * 2048 + k * 1024); } while (0)
#define PG8_MMA(ai, bj, At, Bt) do { __builtin_amdgcn_s_setprio(1); _Pragma("unroll") for (int m = 0; m < 4; ++m) _Pragma("unroll") for (int n = 0; n < 2; ++n) _Pragma("unroll") for (int k = 0; k < 2; ++k) \
        acc[ai][bj][m][n] = __builtin_amdgcn_mfma_f32_16x16x32_bf16(Bt[n][k], At[m][k], acc[ai][bj][m][n], 0, 0, 0); __builtin_amdgcn_s_setprio(0); } while (0)
#define PG8_WAIT_V(n) asm volatile("s_waitcnt vmcnt(" #n ")" ::: "memory")
#define PG8_WAIT_L(n) asm volatile("s_waitcnt lgkmcnt(" #n ")" ::: "memory")
#define PG8_BAR __builtin_amdgcn_s_barrier()
#define PG8_SCHED __builtin_amdgcn_sched_barrier(0)
    Unit cur, nxt; int ui = 0;
    if (!S.next(0, cur)) return;
    f32x4 acc[2][2][4][2];
#pragma unroll
    for (int a = 0; a < 2; ++a)
#pragma unroll
        for (int b = 0; b < 2; ++b)
#pragma unroll
            for (int m = 0; m < 4; ++m)
#pragma unroll
                for (int n = 0; n < 2; ++n) acc[a][b][m][n] = (f32x4){0.f, 0.f, 0.f, 0.f};
    bf16x8 At[4][2], B0[2][2], B1[2][2];
    const char* cA = (const char*)g.A + (size_t)cur.pm * tstep; const char* cB = (const char*)g.Bt + (size_t)cur.pn * tstep;
    S.a_ready(cur);
    if constexpr (SP2) {
        PG8_STAGE(PG8_SB(0, 0), cB, voffB); PG8_STAGE(PG8_SB(0, 1), cB + hstep, voffB); PG8_STAGE(PG8_SA(0, 0), cA, voffA); PG8_STAGE(PG8_SA(0, 1), cA + hstep, voffA);
        if (wr == 1) PG8_BAR;
        PG8_WAIT_V(2); PG8_BAR;
        PG8_STAGE(PG8_SB(1, 0), cB + kstep, voffB); PG8_STAGE(PG8_SA(1, 0), cA + kstep, voffA); PG8_STAGE(PG8_SB(1, 1), cB + hstep + kstep, voffB);
        PG8_WAIT_V(6); PG8_BAR;
    } else {
        PG8_STAGE(PG8_SB(0, 0), cB, voffB); PG8_STAGE(PG8_SA(0, 0), cA, voffA); PG8_STAGE(PG8_SB(0, 1), cB + hstep, voffB); PG8_STAGE(PG8_SA(0, 1), cA + hstep, voffA);
        if (wr == 1) PG8_BAR;
        PG8_WAIT_V(4); PG8_BAR;
        PG8_STAGE(PG8_SB(1, 0), cB + kstep, voffB); PG8_STAGE(PG8_SA(1, 0), cA + kstep, voffA); PG8_STAGE(PG8_SB(1, 1), cB + hstep + kstep, voffB);
        PG8_WAIT_V(6); PG8_BAR;
    }
    for (;;) {
        const bool has_next = S.next(ui + 1, nxt);
        const char* nA = has_next ? (const char*)g.A + (size_t)nxt.pm * tstep : cA; const char* nB = has_next ? (const char*)g.Bt + (size_t)nxt.pn * tstep : cB;
        for (int t = 0; t < nt; t += 2) {
            const bool last = (t == nt - 2);
            const char* a1 = cA + (size_t)(t + 1) * kstep;
            const char* a2 = last ? nA : cA + (size_t)(t + 2) * kstep; const char* b2 = last ? nB : cB + (size_t)(t + 2) * kstep;
            const char* a3 = a2 + kstep; const char* b3 = b2 + kstep;
            if (last && has_next) S.a_ready(nxt);
            if constexpr (SP2) {
            PG8_LDB(B0, 0, 0); PG8_LDB(B1, 0, 1); PG8_SCHED; PG8_LDA(At, 0, 0); PG8_STAGE(PG8_SA(1, 1), a1 + hstep, voffA);
            PG8_WAIT_V(8); PG8_WAIT_L(0); PG8_BAR; PG8_MMA(0, 0, At, B0); PG8_MMA(0, 1, At, B1); PG8_BAR; PG8_SCHED;
            PG8_LDA(At, 0, 1); PG8_STAGE(PG8_SB(0, 0), b2, voffB); PG8_STAGE(PG8_SB(0, 1), b2 + hstep, voffB); PG8_STAGE(PG8_SA(0, 0), a2, voffA);
            PG8_WAIT_V(8); PG8_WAIT_L(0); PG8_BAR; PG8_MMA(1, 0, At, B0); PG8_MMA(1, 1, At, B1); PG8_BAR; PG8_SCHED;
            PG8_LDB(B0, 1, 0); PG8_LDB(B1, 1, 1); PG8_SCHED; PG8_LDA(At, 1, 0); PG8_STAGE(PG8_SA(0, 1), a2 + hstep, voffA);
            PG8_WAIT_V(8); PG8_WAIT_L(0); PG8_BAR; PG8_MMA(0, 0, At, B0); PG8_MMA(0, 1, At, B1); PG8_BAR; PG8_SCHED;
            PG8_LDA(At, 1, 1); PG8_STAGE(PG8_SB(1, 0), b3, voffB); PG8_STAGE(PG8_SB(1, 1), b3 + hstep, voffB); PG8_STAGE(PG8_SA(1, 0), a3, voffA);
            PG8_WAIT_V(8); PG8_WAIT_L(0); PG8_BAR; PG8_MMA(1, 0, At, B0); PG8_MMA(1, 1, At, B1); PG8_BAR; PG8_SCHED;
            } else {
            PG8_LDB(B0, 0, 0); PG8_SCHED; PG8_LDA(At, 0, 0); PG8_STAGE(PG8_SA(1, 1), a1 + hstep, voffA);
            PG8_WAIT_L(8); PG8_BAR; PG8_WAIT_L(0); PG8_MMA(0, 0, At, B0); PG8_BAR; PG8_SCHED;
            PG8_LDB(B1, 0, 1); PG8_STAGE(PG8_SB(0, 0), b2, voffB);
            PG8_BAR; PG8_WAIT_L(0); PG8_MMA(0, 1, At, B1); PG8_BAR;
            PG8_LDA(At, 0, 1); PG8_STAGE(PG8_SA(0, 0), a2, voffA);
            PG8_BAR; PG8_WAIT_L(0); PG8_MMA(1, 0, At, B0); PG8_BAR; PG8_SCHED;
            PG8_STAGE(PG8_SB(0, 1), b2 + hstep, voffB);
            PG8_WAIT_V(6); PG8_BAR; PG8_MMA(1, 1, At, B1); PG8_BAR;
            PG8_LDB(B0, 1, 0); PG8_SCHED; PG8_LDA(At, 1, 0); PG8_STAGE(PG8_SA(0, 1), a2 + hstep, voffA);
            PG8_WAIT_L(8); PG8_BAR; PG8_WAIT_L(0); PG8_MMA(0, 0, At, B0); PG8_BAR; PG8_SCHED;
            PG8_LDB(B1, 1, 1); PG8_STAGE(PG8_SB(1, 0), b3, voffB);
            PG8_BAR; PG8_WAIT_L(0); PG8_MMA(0, 1, At, B1); PG8_BAR;
            PG8_LDA(At, 1, 1); PG8_STAGE(PG8_SA(1, 0), a3, voffA);
            PG8_BAR; PG8_WAIT_L(0); PG8_MMA(1, 0, At, B0); PG8_BAR; PG8_SCHED;
            PG8_STAGE(PG8_SB(1, 1), b3 + hstep, voffB);
            PG8_WAIT_V(6); PG8_BAR; PG8_MMA(1, 1, At, B1); PG8_BAR;
            }
        }
        if constexpr (ALIGN_EPI) { if (wr == 0) PG8_BAR; }
        if constexpr (!Epi::AFTER_DRAIN) { E(acc, cur, wr, wc, fr, fq); S.done(cur); }
        if (!has_next) break;
#pragma unroll
        for (int a = 0; a < 2; ++a)
#pragma unroll
            for (int b = 0; b < 2; ++b)
#pragma unroll
                for (int m = 0; m < 4; ++m)
#pragma unroll
                    for (int n = 0; n < 2; ++n) acc[a][b][m][n] = (f32x4){0.f, 0.f, 0.f, 0.f};
        cur = nxt; cA = nA; cB = nB; ++ui;
        if constexpr (ALIGN_EPI) { if (wr == 1) PG8_BAR; }
    }
    PG8_WAIT_V(0);
    if constexpr (!ALIGN_EPI) { if (wr == 0) PG8_BAR; }
    PG8_BAR;
    if constexpr (Epi::AFTER_DRAIN) { E.fused(acc, cur, wr, wc, fr, fq, lds, wid, lane); S.done(cur); }
#undef PG8_SA
#undef PG8_SB
#undef PG8_STAGE
#undef PG8_LDA
#undef PG8_LDB
#undef PG8_MMA
#undef PG8_WAIT_V
#undef PG8_WAIT_L
#undef PG8_BAR
#undef PG8_SCHED
}
}

typedef unsigned short bf16_t;
typedef short bf16x8 __attribute__((ext_vector_type(8)));
typedef short s16x4 __attribute__((ext_vector_type(4)));
typedef float f32x4 __attribute__((ext_vector_type(4)));
typedef float f32x2 __attribute__((ext_vector_type(2)));
typedef float f32x16 __attribute__((ext_vector_type(16)));
typedef unsigned u32x4 __attribute__((ext_vector_type(4)));
typedef unsigned u32x2 __attribute__((ext_vector_type(2)));
using pg8::cvt_pk_bf16;
__device__ __forceinline__ bf16_t f2bf(float f) { return (bf16_t)(cvt_pk_bf16(f, f) & 0xffffu); }
__device__ __forceinline__ float bf2f(unsigned v) { return __uint_as_float(v << 16); }
__device__ __forceinline__ float bflo(unsigned w) { return __uint_as_float(w << 16); }
__device__ __forceinline__ float bfhi(unsigned w) { return __uint_as_float(w & 0xffff0000u); }
__device__ __forceinline__ float shfl_xor_l(float v, int o, int lane) { return __int_as_float(__builtin_amdgcn_ds_bpermute((lane ^ o) << 2, __float_as_int(v))); }
__device__ __forceinline__ float wave_sum(float v, int lane) {
#pragma unroll
    for (int o = 1; o < 64; o <<= 1) v += shfl_xor_l(v, o, lane);
    return v;
}
__device__ __forceinline__ int crow(int r, int hi) { return (r & 3) + 8 * (r >> 2) + 4 * hi; }
__device__ __forceinline__ float* xrow2(float* out, unsigned char* ws, int m) {
    const int b = m / RPB, j = m - b * RPB;
    return j < CTXL ? (float*)(ws + WS_XC) + (size_t)(b * CTXL + j) * DM : out + ((size_t)b * SEQ + (j - CTXL)) * DM;
}
__device__ __forceinline__ const float* modvec2(const unsigned char* ws, int l, int m) {
    const int b = m / RPB, j = m - b * RPB; const int s = j < CTXL ? 2 : b;
    return (const float*)(ws + WS_SMALL + SM_MOD) + (size_t)(l * 3 + s) * 6144;
}
#define xrow(p, m) xrow2((p).out, (p).ws, (m))
#define modvec(p, l, m) modvec2((p).ws, (l), (m))

constexpr float QSCALE = 0.125f * 1.4426950408889634f;
struct EpiIn {
    static constexpr bool PERM = false, AFTER_DRAIN = false;
    bf16_t* P; const float* rc; const float* rs;
    __device__ __forceinline__ void operator()(const f32x4 (&acc)[2][2][4][2], const pg8::Unit& u, int wr, int wc, int fr, int fq) const {
        const int tb = u.pm % 65;
        const bool rope = (tb != 0) && (u.pn < 4);
#pragma unroll
        for (int ai = 0; ai < 2; ++ai)
#pragma unroll
            for (int m = 0; m < 4; ++m) {
                const int lr = ai * 128 + wr * 64 + m * 16 + fr;
                bf16_t* rowp = P + ((size_t)u.pm * 256 + lr) * NIN + u.pn * 256 + wc * 32 + 4 * fq;
                const int t = (tb - 1) * 256 + lr;
                const int pos = (wc & 1) ? (t & 63) : (t >> 6);
                f32x4 cv = (f32x4){1.f, 1.f, 1.f, 1.f}, sv = (f32x4){0.f, 0.f, 0.f, 0.f};
                if (rope) { cv = *(const f32x4*)(rc + pos * 16 + 4 * fq); sv = *(const f32x4*)(rs + pos * 16 + 4 * fq); }
#pragma unroll
                for (int bj = 0; bj < 2; ++bj) {
                    const f32x4 v0 = acc[ai][bj][m][0], v1 = acc[ai][bj][m][1];
                    f32x4 o0 = v0 * cv - v1 * sv, o1 = v1 * cv + v0 * sv;
                    if (u.pn < 2) { o0 = o0 * QSCALE; o1 = o1 * QSCALE; }
                    u32x2 w0, w1; w0.x = cvt_pk_bf16(o0[0], o0[1]); w0.y = cvt_pk_bf16(o0[2], o0[3]); w1.x = cvt_pk_bf16(o1[0], o1[1]); w1.y = cvt_pk_bf16(o1[2], o1[3]);
                    *(u32x2*)(rowp + bj * 128) = w0; *(u32x2*)(rowp + bj * 128 + 16) = w1;
                }
            }
    }
};
struct EpiRes {
    static constexpr bool PERM = false, AFTER_DRAIN = false;
    float* out; unsigned char* ws; int l; int goff;
    __device__ __forceinline__ void operator()(const f32x4 (&acc)[2][2][4][2], const pg8::Unit& u, int wr, int wc, int fr, int fq) const {
        const float* gv = modvec2(ws, l, u.pm * 256) + goff;
        const int col0 = u.pn * 256 + wc * 32 + 4 * fq;
        f32x4 g[2][2];
#pragma unroll
        for (int bj = 0; bj < 2; ++bj)
#pragma unroll
            for (int n = 0; n < 2; ++n) g[bj][n] = *(const f32x4*)(gv + col0 + bj * 128 + n * 16);
        float* xb = xrow2(out, ws, u.pm * 256);
#pragma unroll
        for (int ai = 0; ai < 2; ++ai)
#pragma unroll
            for (int m = 0; m < 4; ++m) {
                float* rp = xb + (size_t)(ai * 128 + wr * 64 + m * 16 + fr) * DM + col0;
#pragma unroll
                for (int bj = 0; bj < 2; ++bj)
#pragma unroll
                    for (int n = 0; n < 2; ++n) { f32x4* q = (f32x4*)(rp + bj * 128 + n * 16); const f32x4 xv = *q; *q = xv * DN_ALPHA + g[bj][n] * acc[ai][bj][m][n]; }
            }
    }
};
struct EpiUp {
    static constexpr bool PERM = false, AFTER_DRAIN = false;
    bf16_t* HID;
    __device__ __forceinline__ void operator()(const f32x4 (&acc)[2][2][4][2], const pg8::Unit& u, int wr, int wc, int fr, int fq) const {
#pragma unroll
        for (int ai = 0; ai < 2; ++ai)
#pragma unroll
            for (int m = 0; m < 4; ++m) {
                bf16_t* rowp = HID + ((size_t)u.pm * 256 + ai * 128 + wr * 64 + m * 16 + fr) * DFF + u.pn * 256 + wc * 32 + 4 * fq;
#pragma unroll
                for (int bj = 0; bj < 2; ++bj)
#pragma unroll
                    for (int n = 0; n < 2; ++n) { f32x4 v = acc[ai][bj][m][n];
                        v[0] = fmaxf(v[0], 0.f); v[1] = fmaxf(v[1], 0.f); v[2] = fmaxf(v[2], 0.f); v[3] = fmaxf(v[3], 0.f); v = v * v;
                        u32x2 w; w.x = cvt_pk_bf16(v[0], v[1]); w.y = cvt_pk_bf16(v[2], v[3]); *(u32x2*)(rowp + bj * 128 + n * 16) = w; }
            }
    }
};

struct XOrder {
    pg8::StaticOrder S;
    __device__ __forceinline__ void init(int N, int G, int c) { S.init(NBATCH * SEQ, N, G, c); }
    __device__ __forceinline__ bool next(int i, pg8::Unit& u) const { if (!S.next(i, u)) return false; u.pm += 1 + (u.pm >= 64 ? 1 : 0); return true; }
    __device__ __forceinline__ void a_ready(const pg8::Unit&) const {}
    __device__ __forceinline__ void done(const pg8::Unit&) const {}
};
template <class F>
__device__ __forceinline__ void ctx_gemm(const bf16_t* A, int lda, const bf16_t* Bt, int K, int nct, unsigned char* lds, const F& epi, const int wid_s) {
    const int tid_ = mk_tid(wid_s);
    const int lane = tid_ & 63, wid = __builtin_amdgcn_readfirstlane(tid_ >> 6), r = lane & 31, h = lane >> 5, kq = wid & 3, tp = wid >> 2;
    float* red = (float*)lds;
    const int ntile = 16 * nct, Kq = K >> 2;
    for (int t = blockIdx.x; 2 * t < ntile; t += gridDim.x) {
        const int T = 2 * t + tp, rt = T & 15, ct = T >> 4;
        const int row0 = (rt >> 3) * RPB + (rt & 7) * 32;
        const bf16_t* ap = A + (size_t)(row0 + r) * lda + kq * Kq + 8 * h;
        const bf16_t* bp = Bt + (size_t)(32 * ct + r) * K + kq * Kq + 8 * h;
        f32x16 acc = {};
#pragma unroll 8
        for (int k = 0; k < Kq; k += 16) { const bf16x8 a = *(const bf16x8*)(ap + k), b = *(const bf16x8*)(bp + k); acc = __builtin_amdgcn_mfma_f32_32x32x16_bf16(a, b, acc, 0, 0, 0); }
        if (kq != 0) {
#pragma unroll
            for (int reg = 0; reg < 16; ++reg) red[((tp * 4 + kq) * 16 + reg) * 64 + lane] = acc[reg];
        }
        __syncthreads();
        if (kq == 0) {
#pragma unroll
            for (int reg = 0; reg < 16; ++reg) acc[reg] += red[((tp * 4 + 1) * 16 + reg) * 64 + lane] + red[((tp * 4 + 2) * 16 + reg) * 64 + lane] + red[((tp * 4 + 3) * 16 + reg) * 64 + lane];
            epi(acc, row0, 32 * ct, r, h);
        }
        __syncthreads();
    }
}
struct CEpiIn { bf16_t* P;
    __device__ __forceinline__ void operator()(const f32x16& acc, int row0, int col0, int r, int h) const { const int col = col0 + r; const float sc = col < 512 ? QSCALE : 1.f;
#pragma unroll
        for (int reg = 0; reg < 16; ++reg) P[(size_t)(row0 + crow(reg, h)) * NIN + col] = f2bf(acc[reg] * sc); } };
struct CEpiRes { float* out; unsigned char* ws; int l; int goff;
    __device__ __forceinline__ void operator()(const f32x16& acc, int row0, int col0, int r, int h) const { const int col = col0 + r;
        const float g = ((const float*)(ws + WS_SMALL + SM_MOD))[(size_t)(l * 3 + 2) * 6144 + goff + col];
#pragma unroll
        for (int reg = 0; reg < 16; ++reg) { float* xp = xrow2(out, ws, row0 + crow(reg, h)) + col; *xp = *xp * DN_ALPHA + g * acc[reg]; } } };
struct CEpiUp { bf16_t* HID;
    __device__ __forceinline__ void operator()(const f32x16& acc, int row0, int col0, int r, int h) const { const int col = col0 + r;
#pragma unroll
        for (int reg = 0; reg < 16; ++reg) { const float v = fmaxf(acc[reg], 0.f); HID[(size_t)(row0 + crow(reg, h)) * DFF + col] = f2bf(v * v); } } };

namespace att {
constexpr int NW = 8, QBLK = 32, KVBLK = 64;
constexpr float SCALE = 0.125f, THR = 8.f;
constexpr int LDQ = NIN, LDK = NIN, LDO = DM;
constexpr int SHM_V = KVBLK * 128 * 2, SHM_K = KVBLK * 64 * 2, SHM_ATTN = 2 * SHM_V + 2 * SHM_K + NW * 64 * 4;
#define KSWZ(row, colB) ((row) * 128 + ((colB) ^ ((((row) >> 1) & 7) << 4)))
#define SBAR() __builtin_amdgcn_sched_barrier(0)
__device__ __forceinline__ unsigned cvtpk(float lo, float hi) { unsigned r; asm volatile("v_cvt_pk_bf16_f32 %0, %1, %2" : "=v"(r) : "v"(lo), "v"(hi)); return r; }
constexpr float THRL = THR * 1.4426950408889634f;
template <bool FIRST>
__device__ __forceinline__ void partialSM(f32x16& p0, f32x16& p1, float& m_reg, f32x16& negm, float& alpha) {
  float a = fmaxf(fmaxf(p0[0], p0[1]), p1[0]), b = fmaxf(fmaxf(p0[2], p0[3]), p1[1]); a = fmaxf(fmaxf(a, p1[2]), p1[3]);
#pragma unroll
  for (int r = 4; r < 16; r += 4) { a = fmaxf(fmaxf(a, p0[r]), p0[r + 1]); b = fmaxf(fmaxf(b, p0[r + 2]), p0[r + 3]); a = fmaxf(fmaxf(a, p1[r]), p1[r + 1]); b = fmaxf(fmaxf(b, p1[r + 2]), p1[r + 3]); }
  float pmax = fmaxf(a, b);
  { auto rr = __builtin_amdgcn_permlane32_swap(__float_as_uint(pmax), __float_as_uint(pmax), false, false);
    pmax = fmaxf(__uint_as_float(rr[0]), __uint_as_float(rr[1])); }
  if (!FIRST && __builtin_expect(__all(pmax <= THRL), 1)) { alpha = 1.f; }
  else { const float dl = FIRST ? pmax : fmaxf(pmax, 0.f); m_reg += dl; alpha = FIRST ? 1.f : __builtin_amdgcn_exp2f(-dl);
#pragma unroll
    for (int r = 0; r < 16; ++r) { p0[r] -= dl; p1[r] -= dl; }
    const float nm = -m_reg;
#pragma unroll
    for (int r = 0; r < 16; ++r) negm[r] = nm;
    asm volatile("" : "+v"(negm)); }
#pragma unroll
  for (int r = 0; r < 16; ++r) p0[r] = __builtin_amdgcn_exp2f(p0[r]);
}
__device__ __forceinline__ void finishSM(f32x16& p0, f32x16& p1, float alpha, float& l_reg, bf16x8& pa0, bf16x8& pa1, bf16x8& pa2, bf16x8& pa3) {
#pragma unroll
  for (int r = 0; r < 16; ++r) p1[r] = __builtin_amdgcn_exp2f(p1[r]);
  f32x2 s2 = (f32x2){p0[0], p0[1]};
#pragma unroll
  for (int r = 2; r < 16; r += 2) s2 += (f32x2){p0[r], p0[r + 1]};
#pragma unroll
  for (int r = 0; r < 16; r += 2) s2 += (f32x2){p1[r], p1[r + 1]};
  float ps = s2.x + s2.y;
  { auto rr = __builtin_amdgcn_permlane32_swap(__float_as_uint(ps), __float_as_uint(ps), false, false);
    ps = __uint_as_float(rr[0]) + __uint_as_float(rr[1]); }
  l_reg = l_reg * alpha + ps;
#define PK4(P, BASE, OUT) do { unsigned a0 = cvtpk(P[BASE + 0], P[BASE + 1]), a1 = cvtpk(P[BASE + 2], P[BASE + 3]);   \
    unsigned b0 = cvtpk(P[BASE + 4], P[BASE + 5]), b1 = cvtpk(P[BASE + 6], P[BASE + 7]);                              \
    auto r0 = __builtin_amdgcn_permlane32_swap(a0, b0, false, false); auto r1 = __builtin_amdgcn_permlane32_swap(a1, b1, false, false); \
    u32x4 w = {r0[0], r1[0], r0[1], r1[1]}; OUT = *reinterpret_cast<bf16x8*>(&w); } while (0)
  PK4(p0, 0, pa0); PK4(p0, 8, pa1); PK4(p1, 0, pa2); PK4(p1, 8, pa3);
#undef PK4
}
__device__ __forceinline__ void qkt(f32x16& p0, f32x16& p1, const char* Ks, const bf16x8* qr, const f32x16& negm, int r32, int hi) {
#pragma unroll
  for (int d0 = 0; d0 < 4; ++d0) { const int cb = (d0 * 16 + hi * 8) * 2;
    bf16x8 b0 = *reinterpret_cast<const bf16x8*>(Ks + KSWZ(r32, cb));
    bf16x8 b1 = *reinterpret_cast<const bf16x8*>(Ks + KSWZ(32 + r32, cb));
    if (d0 == 0) { p0 = __builtin_amdgcn_mfma_f32_32x32x16_bf16(b0, qr[0], negm, 0, 0, 0); p1 = __builtin_amdgcn_mfma_f32_32x32x16_bf16(b1, qr[0], negm, 0, 0, 0); }
    else { p0 = __builtin_amdgcn_mfma_f32_32x32x16_bf16(b0, qr[d0], p0, 0, 0, 0); p1 = __builtin_amdgcn_mfma_f32_32x32x16_bf16(b1, qr[d0], p1, 0, 0, 0); } }
}
__device__ __forceinline__ int v_st(int k, int c) { const int kk = (k & ~0xC) | ((k & 4) << 1) | ((k & 8) >> 1); return ((kk >> 3) * 4 + (c >> 5)) * 512 + ((kk & 7) * 32 + (c & 31)) * 2; }
__device__ __forceinline__ int v_rd_base(int lane) { return ((lane & 3) << 3) | (((lane >> 2) & 3) << 6) | (((lane >> 4) & 1) << 5) | (((lane >> 5) & 1) << 8); }
constexpr int v_rd_off(int d0, int ks, int half) { return d0 * 512 + ks * 4096 + half * 2048; }
template <int OFF> __device__ __forceinline__ s16x4 tr_read(int vb) {
  s16x4 r; asm volatile("ds_read_b64_tr_b16 %0, %1 offset:%2" : "=&v"(r) : "v"(vb), "i"(OFF) : "memory"); return r;
}
template <int D0> __device__ __forceinline__ void pv_one(f32x16& od, int vb, bf16x8 pa0, bf16x8 pa1, bf16x8 pa2, bf16x8 pa3) {
  const s16x4 l0 = tr_read<v_rd_off(D0, 0, 0)>(vb), h0 = tr_read<v_rd_off(D0, 0, 1)>(vb), l1 = tr_read<v_rd_off(D0, 1, 0)>(vb), h1 = tr_read<v_rd_off(D0, 1, 1)>(vb);
  const s16x4 l2 = tr_read<v_rd_off(D0, 2, 0)>(vb), h2 = tr_read<v_rd_off(D0, 2, 1)>(vb), l3 = tr_read<v_rd_off(D0, 3, 0)>(vb), h3 = tr_read<v_rd_off(D0, 3, 1)>(vb);
  asm volatile("s_waitcnt lgkmcnt(0)" ::: "memory"); SBAR();
#define PK(L, H) (bf16x8){L[0], L[1], L[2], L[3], H[0], H[1], H[2], H[3]}
  od = __builtin_amdgcn_mfma_f32_32x32x16_bf16(pa0, PK(l0, h0), od, 0, 0, 0);
  od = __builtin_amdgcn_mfma_f32_32x32x16_bf16(pa1, PK(l1, h1), od, 0, 0, 0);
  od = __builtin_amdgcn_mfma_f32_32x32x16_bf16(pa2, PK(l2, h2), od, 0, 0, 0);
  od = __builtin_amdgcn_mfma_f32_32x32x16_bf16(pa3, PK(l3, h3), od, 0, 0, 0);
#undef PK
}
__device__ __forceinline__ void pv_d0(f32x16* o, int vb, bf16x8 pa0, bf16x8 pa1, bf16x8 pa2, bf16x8 pa3) {
  pv_one<0>(o[0], vb, pa0, pa1, pa2, pa3); pv_one<1>(o[1], vb, pa0, pa1, pa2, pa3); pv_one<2>(o[2], vb, pa0, pa1, pa2, pa3); pv_one<3>(o[3], vb, pa0, pa1, pa2, pa3);
}
__device__ __forceinline__ void attn_unit(const bf16_t* Qb, const bf16_t* Kh, const bf16_t* Vh, bf16_t* Ob, int seq, char* lds, const int wid_s) {
  const int tid_ = mk_tid(wid_s);
  const int tid = tid_, wid = tid >> 6, lane = tid & 63, r32 = lane & 31, hi = lane >> 5;
  char* V_lds = lds; char* K_lds = lds + 2 * SHM_V;
  float* ws = (float*)(lds + 2 * SHM_V + 2 * SHM_K) + wid * 64; float* li_l = ws; float* al_l = ws + 32;
  float m_reg = 0.f, l_reg = 0; f32x16 o[4] = {}; bf16x8 qr[4]; f32x16 negm = f32x16{}; asm volatile("" : "+v"(negm));
  const bf16_t* Qw = Qb + (long)(wid * QBLK + r32) * LDQ + hi * 8;
#pragma unroll
  for (int d0 = 0; d0 < 4; ++d0) qr[d0] = *reinterpret_cast<const bf16x8*>(Qw + d0 * 16);
  const int sr = tid >> 4, sc = (tid & 15) * 8, vst0 = v_st(sr, sc), vst1 = v_st(32 + sr, sc);
  const int kr = tid >> 3, kc = (tid & 7) * 8, kst = KSWZ(kr, kc * 2);
  const int vb0 = (int)(uintptr_t)V_lds + v_rd_base(lane);
  struct { bf16x8 vs0, vs1, ks0; } sr_[2];
#define SLOAD(i, k0) do { sr_[i].vs0 = *reinterpret_cast<const bf16x8*>(&Vh[(long)((k0) + sr) * LDK + sc]); sr_[i].vs1 = *reinterpret_cast<const bf16x8*>(&Vh[(long)((k0) + 32 + sr) * LDK + sc]); \
    sr_[i].ks0 = *reinterpret_cast<const bf16x8*>(&Kh[(long)((k0) + kr) * LDK + kc]); } while (0)
#define SWRITE(b, i) do { *(bf16x8*)(V_lds + (b) * SHM_V + vst0) = sr_[i].vs0; *(bf16x8*)(V_lds + (b) * SHM_V + vst1) = sr_[i].vs1; \
    *(bf16x8*)(K_lds + (b) * SHM_K + kst) = sr_[i].ks0; } while (0)
#define SWAIT() asm volatile("s_waitcnt vmcnt(3)" ::: "memory")
#define RESC(a) do { if (__any((a) < 1.f)) { if (hi == 0) al_l[r32] = (a); asm volatile("s_waitcnt lgkmcnt(0)" ::: "memory"); \
    _Pragma("unroll") for (int d = 0; d < 4; ++d) _Pragma("unroll") for (int r = 0; r < 16; ++r) o[d][r] *= al_l[crow(r, hi)]; } } while (0)
  f32x16 pA0, pA1, pB0, pB1; float alA, alB; bf16x8 pa0, pa1, pa2, pa3; const int NT = seq / KVBLK;
  constexpr int SE = 0, SO = 1;
  SLOAD(SE, 0); asm volatile("s_waitcnt vmcnt(0)" ::: "memory"); SWRITE(0, SE); __syncthreads();
  qkt(pA0, pA1, K_lds, qr, negm, r32, hi); partialSM<true>(pA0, pA1, m_reg, negm, alA);
  SLOAD(SO, KVBLK); if (2 < NT) SLOAD(SE, 2 * KVBLK);
  SWAIT(); SWRITE(1, SO); __syncthreads();
  for (int j = 1; j + 1 < NT; j += 2) {
    SBAR(); qkt(pB0, pB1, K_lds + SHM_K, qr, negm, r32, hi);
    finishSM(pA0, pA1, alA, l_reg, pa0, pa1, pa2, pa3); SBAR();
    SLOAD(SO, (j + 2) * KVBLK); SBAR();
    pv_d0(o, vb0, pa0, pa1, pa2, pa3); partialSM<false>(pB0, pB1, m_reg, negm, alB);
    __syncthreads(); SWAIT(); SWRITE(0, SE);
    RESC(alB); __syncthreads();
    SBAR(); qkt(pA0, pA1, K_lds, qr, negm, r32, hi);
    finishSM(pB0, pB1, alB, l_reg, pa0, pa1, pa2, pa3); SBAR();
    if (j + 3 < NT) SLOAD(SE, (j + 3) * KVBLK); SBAR();
    pv_d0(o, vb0 + SHM_V, pa0, pa1, pa2, pa3); partialSM<false>(pA0, pA1, m_reg, negm, alA);
    __syncthreads(); SWAIT(); SWRITE(1, SO);
    RESC(alA); __syncthreads();
  }
  SBAR(); qkt(pB0, pB1, K_lds + SHM_K, qr, negm, r32, hi);
  finishSM(pA0, pA1, alA, l_reg, pa0, pa1, pa2, pa3); SBAR();
  pv_d0(o, vb0, pa0, pa1, pa2, pa3); partialSM<false>(pB0, pB1, m_reg, negm, alB);
  __syncthreads(); RESC(alB);
  finishSM(pB0, pB1, alB, l_reg, pa0, pa1, pa2, pa3); SBAR();
  pv_d0(o, vb0 + SHM_V, pa0, pa1, pa2, pa3);
  if (hi == 0) li_l[r32] = l_reg; asm volatile("s_waitcnt lgkmcnt(0)" ::: "memory");
  float rli[16];
#pragma unroll
  for (int r = 0; r < 16; ++r) rli[r] = __builtin_amdgcn_rcpf(li_l[crow(r, hi)]);
  bf16_t* Ow = Ob + (long)(wid * QBLK) * LDO;
#pragma unroll
  for (int r = 0; r < 16; ++r) { const int orow = crow(r, hi);
#pragma unroll
    for (int d0 = 0; d0 < 4; ++d0) Ow[(long)orow * LDO + d0 * 32 + r32] = f2bf(o[d0][r] * rli[r]); }
  __syncthreads();
#undef SLOAD
#undef SWRITE
#undef SWAIT
#undef RESC
}
#undef KSWZ
#undef SBAR
}

#define MFMA32(a, b, c) __builtin_amdgcn_mfma_f32_32x32x16_bf16(a, b, c, 0, 0, 0)
__device__ __forceinline__ bf16x8 ldB_strided(const bf16_t* p, size_t ldb) {
    bf16x8 b;
#pragma unroll
    for (int j = 0; j < 8; ++j) b[j] = (short)p[(size_t)j * ldb];
    return b;
}
__device__ __forceinline__ void four_stage0(const bf16_t* P, const bf16_t* W0T, bf16_t* Zr, bf16_t* Zi, int rt, int g, int lane) {
    const int r = lane & 31, h = lane >> 5;
    const bf16_t* Ap = P + (size_t)(32 * rt + r) * NIN + C_F + 64 * g + 8 * h;
    f32x16 acc[4] = {};
#pragma unroll
    for (int ks = 0; ks < 4; ++ks) { const bf16x8 a = *(const bf16x8*)(Ap + 16 * ks);
#pragma unroll
        for (int ct = 0; ct < 4; ++ct) { const bf16x8 b = *(const bf16x8*)(W0T + (32 * ct + r) * 64 + 16 * ks + 8 * h); acc[ct] = MFMA32(a, b, acc[ct]); } }
#pragma unroll
    for (int ct = 0; ct < 4; ++ct) { bf16_t* Zp = (ct < 2 ? Zr : Zi) + 64 * g + 32 * (ct & 1) + r;
#pragma unroll
        for (int reg = 0; reg < 16; ++reg) Zp[(size_t)(32 * rt + crow(reg, h)) * 256] = f2bf(acc[ct][reg]); }
}
__device__ __forceinline__ void four_stage1(const bf16_t* Zr, const bf16_t* Zi, const bf16_t* W1, const f32x2* tw, bf16_t* Ypr, bf16_t* Ypi, int b, int cb, int lane) {
    const int r = lane & 31, h = lane >> 5; const int n0 = 32 * cb, t2 = n0 >> 8, ch0 = n0 & 255;
    f32x16 acc[8] = {};
#pragma unroll
    for (int part = 0; part < 2; ++part) { const bf16_t* Zp = (part ? Zi : Zr) + (size_t)(b * RPB + CTXL + t2) * 256 + ch0 + r;
        for (int kk = 0; kk < 128; kk += 16) { const bf16x8 bf = ldB_strided(Zp + (size_t)(kk + 8 * h) * (128 * 256), (size_t)128 * 256);
#pragma unroll
            for (int mt = 0; mt < 8; ++mt) { const bf16x8 a = *(const bf16x8*)(W1 + (32 * mt + r) * 256 + part * 128 + kk + 8 * h); acc[mt] = MFMA32(a, bf, acc[mt]); } } }
#pragma unroll
    for (int mt = 0; mt < 4; ++mt)
#pragma unroll
        for (int reg = 0; reg < 16; ++reg) { const int k1 = 32 * mt + crow(reg, h); const f32x2 cs = tw[k1 * 128 + t2];
            const float yr = acc[mt][reg], yi = acc[mt + 4][reg]; const size_t o = ((size_t)(b * 128 + k1) * 128 + t2) * 256 + ch0 + r;
            Ypr[o] = f2bf(cs.x * yr + cs.y * yi); Ypi[o] = f2bf(cs.x * yi - cs.y * yr); }
}
__device__ __forceinline__ void four_stage2(const bf16_t* Ypr, const bf16_t* Ypi, const bf16_t* W2, bf16_t* MIX, int b, int k1, int cb, int lane) {
    const int r = lane & 31, h = lane >> 5;
    f32x16 acc[4] = {};
#pragma unroll
    for (int part = 0; part < 2; ++part) { const bf16_t* Yp = (part ? Ypi : Ypr) + ((size_t)(b * 128 + k1) * 128) * 256 + 32 * cb + r;
        for (int kk = 0; kk < 128; kk += 16) { const bf16x8 bf = ldB_strided(Yp + (size_t)(kk + 8 * h) * 256, 256);
#pragma unroll
            for (int mt = 0; mt < 4; ++mt) { const bf16x8 a = *(const bf16x8*)(W2 + (32 * mt + r) * 256 + part * 128 + kk + 8 * h); acc[mt] = MFMA32(a, bf, acc[mt]); } } }
#pragma unroll
    for (int mt = 0; mt < 4; ++mt)
#pragma unroll
        for (int reg = 0; reg < 16; ++reg) { const int k2 = 32 * mt + crow(reg, h);
            MIX[(size_t)(b * RPB + CTXL + k1 + 128 * k2) * DM + 768 + 32 * cb + r] = f2bf(acc[mt][reg]); }
}
__device__ __forceinline__ void four_ctx(const bf16_t* Zr, const bf16_t* Zi, const bf16_t* WC, bf16_t* MIX, int b, int cb, int lane) {
    const int r = lane & 31, h = lane >> 5;
    f32x16 acc[8] = {};
#pragma unroll
    for (int part = 0; part < 2; ++part) { const bf16_t* Zp = (part ? Zi : Zr) + (size_t)(b * RPB) * 256 + 32 * cb + r;
        for (int kk = 0; kk < 256; kk += 16) { const bf16x8 bf = ldB_strided(Zp + (size_t)(kk + 8 * h) * 256, 256);
#pragma unroll
            for (int mt = 0; mt < 8; ++mt) { const bf16x8 a = *(const bf16x8*)(WC + (32 * mt + r) * 512 + part * 256 + kk + 8 * h); acc[mt] = MFMA32(a, bf, acc[mt]); } } }
#pragma unroll
    for (int mt = 0; mt < 8; ++mt)
#pragma unroll
        for (int reg = 0; reg < 16; ++reg) { const int k = 32 * mt + crow(reg, h);
            MIX[(size_t)(b * RPB + k) * DM + 768 + 32 * cb + r] = f2bf(acc[mt][reg]); }
}

__device__ __forceinline__ void ln_mod_row(float* xr, const float* g, const float* bta, const float* sh, const float* sc, bf16_t* hrow, int lane, bool do_ln) {
    f32x4 v[4]; float s = 0.f;
#pragma unroll
    for (int j = 0; j < 4; ++j) { v[j] = *((const f32x4*)xr + lane + 64 * j); s += (v[j][0] + v[j][1]) + (v[j][2] + v[j][3]); }
    if (do_ln) {
        const float mean = wave_sum(s, lane) * (1.f / DM); float s2 = 0.f;
#pragma unroll
        for (int j = 0; j < 4; ++j) { v[j] = v[j] - mean; s2 += (v[j][0] * v[j][0] + v[j][1] * v[j][1]) + (v[j][2] * v[j][2] + v[j][3] * v[j][3]); }
        const float rstd = 1.f / sqrtf(wave_sum(s2, lane) * (1.f / DM) + LN_EPS);
#pragma unroll
        for (int j = 0; j < 4; ++j) { const f32x4 gg = *((const f32x4*)g + lane + 64 * j), bb = *((const f32x4*)bta + lane + 64 * j); v[j] = v[j] * rstd * gg + bb; }
    }
#pragma unroll
    for (int j = 0; j < 4; ++j) *((f32x4*)xr + lane + 64 * j) = v[j];
    if (sh) {
#pragma unroll
        for (int j = 0; j < 4; ++j) { const f32x4 a = *((const f32x4*)sh + lane + 64 * j), c = *((const f32x4*)sc + lane + 64 * j); const f32x4 y = v[j] * (c + 1.0f) + a;
            u32x2 w; w.x = cvt_pk_bf16(y[0], y[1]); w.y = cvt_pk_bf16(y[2], y[3]); *((u32x2*)hrow + lane + 64 * j) = w; }
    }
}
__device__ __forceinline__ void conv_row(const bf16_t* P, const float* cw, const float* cbias, bf16_t* MIX, int m, int lane) {
    const int j = m % RPB; const bool hp = !(j == 0 || j == CTXL), hn = !(j == CTXL - 1 || j == RPB - 1);
    const bf16_t* pr = P + (size_t)m * NIN + 4 * lane;
    const u32x2 u1 = *(const u32x2*)(pr + C_U), c1 = *(const u32x2*)(pr + C_GC), gb = *(const u32x2*)(pr + C_GB);
    u32x2 u0 = (u32x2){0u, 0u}, c0 = u0, u2 = u0, c2 = u0;
    if (hp) { u0 = *(const u32x2*)(pr - NIN + C_U); c0 = *(const u32x2*)(pr - NIN + C_GC); }
    if (hn) { u2 = *(const u32x2*)(pr + NIN + C_U); c2 = *(const u32x2*)(pr + NIN + C_GC); }
    const f32x4 w0 = *(const f32x4*)(cw + 4 * lane), w1 = *(const f32x4*)(cw + 256 + 4 * lane), w2 = *(const f32x4*)(cw + 512 + 4 * lane), bb = *(const f32x4*)(cbias + 4 * lane);
    const f32x4 z0 = (f32x4){bflo(u0.x) * bflo(c0.x), bfhi(u0.x) * bfhi(c0.x), bflo(u0.y) * bflo(c0.y), bfhi(u0.y) * bfhi(c0.y)};
    const f32x4 z1 = (f32x4){bflo(u1.x) * bflo(c1.x), bfhi(u1.x) * bfhi(c1.x), bflo(u1.y) * bflo(c1.y), bfhi(u1.y) * bfhi(c1.y)};
    const f32x4 z2 = (f32x4){bflo(u2.x) * bflo(c2.x), bfhi(u2.x) * bfhi(c2.x), bflo(u2.y) * bflo(c2.y), bfhi(u2.y) * bfhi(c2.y)};
    const f32x4 gbf = (f32x4){bflo(gb.x), bfhi(gb.x), bflo(gb.y), bfhi(gb.y)};
    const f32x4 y = gbf * (w0 * z0 + w1 * z1 + w2 * z2 + bb);
    u32x2 w; w.x = cvt_pk_bf16(y[0], y[1]); w.y = cvt_pk_bf16(y[2], y[3]);
    *(u32x2*)(MIX + (size_t)m * DM + 512 + 4 * lane) = w;
}
__device__ __forceinline__ void combine_row(const bf16_t* OATT, const float* subw, float lam, float one_m_li, bf16_t* MIX, int m, int lane) {
    const int h = lane >> 4, li = lane & 15;
    const bf16_t* op = OATT + (size_t)m * DM + h * 256 + 8 * li;
    const u32x4 a = *(const u32x4*)op, b = *(const u32x4*)(op + 128);
    float o[8];
    o[0] = bflo(a.x) - lam * bflo(b.x); o[1] = bfhi(a.x) - lam * bfhi(b.x); o[2] = bflo(a.y) - lam * bflo(b.y); o[3] = bfhi(a.y) - lam * bfhi(b.y);
    o[4] = bflo(a.z) - lam * bflo(b.z); o[5] = bfhi(a.z) - lam * bfhi(b.z); o[6] = bflo(a.w) - lam * bflo(b.w); o[7] = bfhi(a.w) - lam * bfhi(b.w);
    float ss = 0.f;
#pragma unroll
    for (int i = 0; i < 8; ++i) ss += o[i] * o[i];
    ss += shfl_xor_l(ss, 1, lane); ss += shfl_xor_l(ss, 2, lane); ss += shfl_xor_l(ss, 4, lane); ss += shfl_xor_l(ss, 8, lane);
    const float rs = (1.f / sqrtf(ss * (1.f / 128.f) + RMS_EPS)) * one_m_li;
    const f32x4 w0 = *(const f32x4*)(subw + 8 * li), w1 = *(const f32x4*)(subw + 8 * li + 4);
    u32x4 w; w.x = cvt_pk_bf16(o[0] * rs * w0[0], o[1] * rs * w0[1]); w.y = cvt_pk_bf16(o[2] * rs * w0[2], o[3] * rs * w0[3]);
    w.z = cvt_pk_bf16(o[4] * rs * w1[0], o[5] * rs * w1[1]); w.w = cvt_pk_bf16(o[6] * rs * w1[2], o[7] * rs * w1[3]);
    *(u32x4*)(MIX + (size_t)m * DM + h * 128 + 8 * li) = w;
}

__device__ __forceinline__ void transpose_item(const float* W, int K, int N, bf16_t* WT, float* scr, int item, int lane) {
    const int nblk = N / 32, kb = item / nblk, nb = item % nblk, k0 = 64 * kb, n0 = 32 * nb;
#pragma unroll 8
    for (int i = 0; i < 32; ++i) { const int kk = 2 * i + (lane >> 5); scr[kk * 33 + (lane & 31)] = W[(size_t)(k0 + kk) * N + n0 + (lane & 31)]; }
    asm volatile("s_waitcnt lgkmcnt(0)" ::: "memory");
    const int c = lane & 7;
#pragma unroll
    for (int j = 0; j < 4; ++j) { const int n = (lane >> 3) + 8 * j; const float* s = scr + (8 * c) * 33 + n;
        u32x4 o; o.x = cvt_pk_bf16(s[0 * 33], s[1 * 33]); o.y = cvt_pk_bf16(s[2 * 33], s[3 * 33]); o.z = cvt_pk_bf16(s[4 * 33], s[5 * 33]); o.w = cvt_pk_bf16(s[6 * 33], s[7 * 33]);
        *(u32x4*)(WT + (size_t)(n0 + n) * K + k0 + 8 * c) = o; }
    asm volatile("s_waitcnt lgkmcnt(0)" ::: "memory");
}
__device__ __forceinline__ float siluf(float x) { return x / (1.f + expf(-x)); }

#define LAS __attribute__((address_space(3)))
#define XB_TMO      128
#define XB_XCNT(j)  (256  + 64 * (j))
#define XB_XSUB(j)  (1280 + 64 * (j))
#define XB_XGEN(j)  (2304 + 64 * (j))
#define XB_TOP      3328
#define XB_TOPGEN   3392
#define XCD_BAR_WORDS 3456
#define XB_SPIN_CAP (1u << 23)

__device__ __forceinline__ unsigned xb_ld(unsigned* p)              { return __hip_atomic_load(p, __ATOMIC_RELAXED, __HIP_MEMORY_SCOPE_AGENT); }
__device__ __forceinline__ unsigned xb_add(unsigned* p, unsigned v) { return __hip_atomic_fetch_add(p, v, __ATOMIC_RELAXED, __HIP_MEMORY_SCOPE_AGENT); }
__device__ __forceinline__ unsigned xb_xcc_id() { return (unsigned)__builtin_amdgcn_s_getreg((3 << 11) | 20) & 0xFu; }
#define XB_SPIN(cond, bar) do { unsigned _sp = 0; while (cond) { __builtin_amdgcn_s_sleep(1); \
    if ((++_sp & 255u) == 0u) { if (xb_ld(&(bar)[XB_TMO])) break; if (_sp > XB_SPIN_CAP) { atomicAdd(&(bar)[XB_TMO], 1u); break; } } } } while (0)

struct XcdBarrier {
    unsigned* bar; unsigned x;
    volatile LAS unsigned* st;
};

__device__ __forceinline__ XcdBarrier xcd_barrier_post(unsigned* bar, volatile LAS unsigned* st) {
    XcdBarrier b; b.bar = bar; b.x = xb_xcc_id(); b.st = st;
    if (threadIdx.x == 0) (void)xb_add(&bar[XB_XCNT(b.x)], 1u);
    return b;
}
__device__ __forceinline__ void xcd_barrier_complete(unsigned* bar, unsigned x, unsigned& nloc, unsigned& nx) {
    const unsigned G = gridDim.x * gridDim.y * gridDim.z;
    unsigned sum, cnt, mine, sp = 0u;
    for (;;) {
        sum = 0u; cnt = 0u; mine = 0u;
#pragma unroll
        for (unsigned j = 0; j < 16; ++j) { const unsigned c = xb_ld(&bar[XB_XCNT(j)]); sum += c; cnt += (c > 0u) ? 1u : 0u; mine = (j == x) ? c : mine; }
        if (sum == G) break;
        __builtin_amdgcn_s_sleep(1);
        if ((++sp & 255u) == 0u) { if (xb_ld(&bar[XB_TMO])) break; if (sp > XB_SPIN_CAP) { atomicAdd(&bar[XB_TMO], 1u); break; } }
    }
    nloc = mine > 0u ? mine : 1u; nx = cnt > 0u ? cnt : 1u;
}

__device__ __forceinline__ void xcd_barrier(const XcdBarrier& b) {
    asm volatile("s_waitcnt vmcnt(0)" ::: "memory");
    __syncthreads();
    if (threadIdx.x == 0) {
        unsigned* bar = b.bar;
        __builtin_amdgcn_s_waitcnt(0);
        unsigned nloc = b.st[0], nx = b.st[1];
        if (nloc == 0u) { xcd_barrier_complete(bar, b.x, nloc, nx); b.st[0] = nloc; b.st[1] = nx; }
        const unsigned old = xb_add(&bar[XB_XSUB(b.x)], 1u);
        const unsigned gen = old / nloc;
        if (old + 1u == (gen + 1u) * nloc) {
            __builtin_amdgcn_fence(__ATOMIC_RELEASE, "agent");
            asm volatile("s_waitcnt vmcnt(0)" ::: "memory");
            const unsigned og = xb_add(&bar[XB_TOP], 1u);
            const unsigned tg = og / nx;
            if (og + 1u == (tg + 1u) * nx) xb_add(&bar[XB_TOPGEN], 1u);
            else XB_SPIN(xb_ld(&bar[XB_TOPGEN]) == tg, bar);
            __builtin_amdgcn_fence(__ATOMIC_ACQUIRE, "agent");
            xb_add(&bar[XB_XGEN(b.x)], 1u);
            asm volatile("s_waitcnt vmcnt(0)" ::: "memory");
        } else {
            XB_SPIN(xb_ld(&bar[XB_XGEN(b.x)]) == gen, bar);
            __builtin_amdgcn_fence(__ATOMIC_ACQUIRE, "agent");
            asm volatile("s_waitcnt vmcnt(0)" ::: "memory");
        }
    }
    __syncthreads();
}

constexpr int LDS_BYTES = 131072 + 1024;
constexpr int REP_ATT = 1, REP_MIXB = 1, REP_CD = 1, REP_GEMM = 1, REP_PRO = 1, EXTRA_SYNCS = 0;
__global__ void __launch_bounds__(512, 2) mega_fwd(Params p) {
    extern __shared__ __attribute__((aligned(16))) unsigned char lds[];
    cg::grid_group grid = cg::this_grid();
    const int tid = threadIdx.x, lane = tid & 63, wid = __builtin_amdgcn_readfirstlane(tid >> 6);
    const int G = gridDim.x, gw = blockIdx.x * 8 + wid, NGW = G * 8;
    unsigned char* ws = p.ws;
    bf16_t* Wt_in = (bf16_t*)(ws + WS_WIN); bf16_t* Wt_out = (bf16_t*)(ws + WS_WOUT); bf16_t* Wt_up = (bf16_t*)(ws + WS_WUP); bf16_t* Wt_dn = (bf16_t*)(ws + WS_WDN);
    float* modv = (float*)(ws + WS_SMALL + SM_MOD); float* ropec = (float*)(ws + WS_SMALL + SM_ROPEC); float* ropes = (float*)(ws + WS_SMALL + SM_ROPES);
    bf16_t* W0T = (bf16_t*)(ws + WS_SMALL + SM_W0T); bf16_t* W1 = (bf16_t*)(ws + WS_SMALL + SM_W1); bf16_t* W2 = (bf16_t*)(ws + WS_SMALL + SM_W2); bf16_t* WC = (bf16_t*)(ws + WS_SMALL + SM_WC);
    f32x2* tw = (f32x2*)(ws + WS_SMALL + SM_TW);
    bf16_t* H = (bf16_t*)(ws + WS_H); bf16_t* MIX = (bf16_t*)(ws + WS_MIX);
    bf16_t* Pb = (bf16_t*)(ws + WS_R + R_P); bf16_t* OATT = (bf16_t*)(ws + WS_R + R_OATT); bf16_t* Zr = (bf16_t*)(ws + WS_R + R_ZR); bf16_t* Zi = (bf16_t*)(ws + WS_R + R_ZI);
    bf16_t* HID = (bf16_t*)(ws + WS_R);
    bf16_t* Ypr = (bf16_t*)(ws + WS_H); bf16_t* Ypi = (bf16_t*)(ws + WS_H + YP_PLANE);
    __attribute__((address_space(3))) unsigned char* lds3 = (__attribute__((address_space(3))) unsigned char*)lds;
    volatile LAS unsigned* misc = (volatile LAS unsigned*)(lds3 + 131072);
    if (tid < 4) misc[tid] = 0u;
    __syncthreads();
    (void)xcd_barrier_post((unsigned*)(ws + WS_CTL), misc);
#define GSYNC() do { XcdBarrier b_; b_.bar = (unsigned*)(p.ws + WS_CTL); b_.x = xb_xcc_id(); b_.st = (volatile LAS unsigned*)((LAS unsigned char*)lds + 131072); xcd_barrier(b_); } while (0)

    for (int rep = 0; rep < REP_PRO; ++rep) {
        float* scr = (float*)(lds + wid * 16384);
        constexpr int I_IN = (DM / 64) * (NIN / 32), I_OUT = (DM / 64) * (DM / 32), I_UP = (DM / 64) * (DFF / 32), I_DN = (DFF / 64) * (DM / 32), I_L = I_IN + I_OUT + I_UP + I_DN;
        for (int it = gw; it < DEPTH * I_L; it += NGW) {
            const int l = it / I_L; int r = it - l * I_L;
            if (r < I_IN) { transpose_item(p.w_in + (size_t)l * DM * NIN, DM, NIN, Wt_in + (size_t)l * NIN * DM, scr, r, lane); continue; } r -= I_IN;
            if (r < I_OUT) { transpose_item(p.w_out + (size_t)l * DM * DM, DM, DM, Wt_out + (size_t)l * DM * DM, scr, r, lane); continue; } r -= I_OUT;
            if (r < I_UP) { transpose_item(p.w_up + (size_t)l * DM * DFF, DM, DFF, Wt_up + (size_t)l * DFF * DM, scr, r, lane); continue; } r -= I_UP;
            transpose_item(p.w_down + (size_t)l * DFF * DM, DFF, DM, Wt_dn + (size_t)l * DM * DFF, scr, r, lane);
        }
        __syncthreads();
        float* sv = (float*)lds; float* red = (float*)(lds + 12288);
        for (int i = tid; i < 3 * DM; i += 512) { const int s = i >> 10, k = i & 1023; sv[i] = siluf(s < 2 ? p.c[s * DM + k] : p.c_ctx[k]); }
        __syncthreads();
        for (int task = blockIdx.x; task < DEPTH * 96; task += G) {
            const int l = task / 96, n = (task % 96) * 64 + lane;
            const float* wp = p.w_mod + (size_t)l * DM * 6144 + n;
            float a0 = 0.f, a1 = 0.f, a2 = 0.f;
#pragma unroll 8
            for (int k = wid * 128; k < wid * 128 + 128; ++k) { const float wv = wp[(size_t)k * 6144]; a0 += sv[k] * wv; a1 += sv[DM + k] * wv; a2 += sv[2 * DM + k] * wv; }
            red[(wid * 3 + 0) * 64 + lane] = a0; red[(wid * 3 + 1) * 64 + lane] = a1; red[(wid * 3 + 2) * 64 + lane] = a2;
            __syncthreads();
            if (wid < 3) { float s = p.b_mod[l * 6144 + n];
#pragma unroll
                for (int w = 0; w < 8; ++w) s += red[(w * 3 + wid) * 64 + lane];
                modv[(size_t)(l * 3 + wid) * 6144 + n] = s; }
            __syncthreads();
        }
        const int gt = blockIdx.x * 512 + tid, NGT = G * 512;
        for (int i = gt; i < 256 * 16; i += NGT) { const int pos = i >> 4, fi = i & 15; double invf = 1.0; for (int q = 0; q < fi; ++q) invf *= 0.5623413251903491;
            const double rev = (double)pos * invf * 0.15915494309189535; const float fr = (float)(rev - floor(rev));
            ropec[i] = __builtin_amdgcn_cosf(fr); ropes[i] = __builtin_amdgcn_sinf(fr); }
        for (int i = gt; i < 128 * 64; i += NGT) { const int n = i >> 6, c = i & 63; const int m = n & 63; const float fr = (float)((m * c) & 63) * (1.f / 64.f);
            W0T[i] = f2bf((n < 64 ? __builtin_amdgcn_cosf(fr) : -__builtin_amdgcn_sinf(fr)) * 0.125f); }
        for (int i = gt; i < 256 * 256; i += NGT) { const int row = i >> 8, col = i & 255; const int k1 = row & 127, t1 = col & 127, po = row >> 7, pi = col >> 7;
            const float fr = (float)((k1 * t1) & 127) * (1.f / 128.f); const float c = __builtin_amdgcn_cosf(fr), s = __builtin_amdgcn_sinf(fr);
            const float v = po == 0 ? (pi == 0 ? c : s) : (pi == 0 ? -s : c); W1[i] = f2bf(v * 0.08838834764831845f); }
        for (int i = gt; i < 128 * 256; i += NGT) { const int k2 = i >> 8, col = i & 255; const int t2 = col & 127, pi = col >> 7;
            const float fr = (float)((k2 * t2) & 127) * (1.f / 128.f); W2[i] = f2bf((pi == 0 ? __builtin_amdgcn_cosf(fr) : __builtin_amdgcn_sinf(fr)) * 0.08838834764831845f); }
        for (int i = gt; i < 256 * 512; i += NGT) { const int k = i >> 9, col = i & 511; const int t = col & 255, pi = col >> 8;
            const float fr = (float)((k * t) & 255) * (1.f / 256.f); WC[i] = f2bf((pi == 0 ? __builtin_amdgcn_cosf(fr) : __builtin_amdgcn_sinf(fr)) * 0.0625f); }
        for (int i = gt; i < 128 * 128; i += NGT) { const int k1 = i >> 7, t2 = i & 127; const float fr = (float)(k1 * t2) * (1.f / 16384.f);
            tw[i] = (f32x2){__builtin_amdgcn_cosf(fr), __builtin_amdgcn_sinf(fr)}; }
    }
    grid.sync();
    for (int m = gw; m < MROWS; m += NGW) {
        const int b = m / RPB, j = m - b * RPB;
        const float* src = j < CTXL ? p.ctx + (size_t)(b * CTXL + j) * DM : p.x + ((size_t)b * SEQ + (j - CTXL)) * DM;
        float* xr = xrow(p, m); const float* mv = modvec(p, 0, m);
        f32x4 v[4];
#pragma unroll
        for (int q = 0; q < 4; ++q) v[q] = *((const f32x4*)src + lane + 64 * q);
#pragma unroll
        for (int q = 0; q < 4; ++q) { *((f32x4*)xr + lane + 64 * q) = v[q];
            const f32x4 a = *((const f32x4*)mv + lane + 64 * q), c = *((const f32x4*)(mv + DM) + lane + 64 * q); const f32x4 y = v[q] * (c + 1.0f) + a;
            u32x2 w; w.x = cvt_pk_bf16(y[0], y[1]); w.y = cvt_pk_bf16(y[2], y[3]); *((u32x2*)(H + (size_t)m * DM) + lane + 64 * q) = w; }
    }
    GSYNC();

#define PHASE_IDS() const int tid_ = mk_tid(wid); const int lane = tid_ & 63; (void)lane
#pragma nounroll
    for (int l = 0; l < DEPTH; ++l) {
        for (int rep = 0; rep < REP_GEMM; ++rep)
        { pg8::Gemm g{H, Wt_in + (size_t)l * NIN * DM, MROWS, NIN, DM}; XOrder S; S.init(NIN, G, (int)blockIdx.x);
          EpiIn E{Pb, ropec, ropes};
          pg8::gemm_phase<EpiIn, XOrder, true, true>(lds3, g, S, E, wid);
          ctx_gemm(H, DM, Wt_in + (size_t)l * NIN * DM, DM, NIN / 32, lds, CEpiIn{Pb}, wid); }
        GSYNC();
        {
            for (int rep = 0; rep < REP_ATT; ++rep)
            for (int uidx = blockIdx.x; uidx < 1024 + 16; uidx += G) {
                int b, h, pm_, qrow0, seq;
                if (uidx < 1024) { const int w = uidx & 255, i = uidx >> 8; const int xg = w & 7, li = w >> 3; b = xg >> 2; h = xg & 3; pm_ = i >> 1; const int qb = (i & 1) * 32 + li;
                    qrow0 = b * RPB + CTXL + qb * 256; seq = RPB; }
                else { const int c = uidx - 1024; b = c >> 3; h = (c >> 1) & 3; pm_ = c & 1; qrow0 = b * RPB; seq = CTXL; }
                const size_t krow0 = (size_t)b * RPB;
                att::attn_unit(Pb + (size_t)qrow0 * NIN + C_Q + h * 128 + pm_ * 64, Pb + krow0 * NIN + C_K + h * 128 + pm_ * 64, Pb + krow0 * NIN + C_V + h * 128,
                               OATT + (size_t)qrow0 * DM + h * 256 + pm_ * 128, seq, (char*)lds, wid);
            }
            PHASE_IDS();
            const float* cw = p.conv_w + (size_t)l * 3 * 256; const float* cbv = p.conv_b + (size_t)l * 256;
            for (int rep = 0; rep < REP_MIXB; ++rep) {
            for (int m = gw; m < MROWS; m += NGW) conv_row(Pb, cw, cbv, MIX, m, lane);
            for (int t = gw; t < (MROWS / 32) * 4; t += NGW) four_stage0(Pb, W0T, Zr, Zi, t >> 2, t & 3, lane); }
        }
        GSYNC();
        for (int rep = 0; rep < REP_CD; ++rep) {
        {
            PHASE_IDS();
            for (int t = gw; t < NBATCH * 1024; t += NGW) four_stage1(Zr, Zi, W1, tw, Ypr, Ypi, t >> 10, t & 1023, lane);
            for (int t = gw; t < NBATCH * 8; t += NGW) four_ctx(Zr, Zi, WC, MIX, t >> 3, t & 7, lane);
            const float* lp = p.diff_lambda + (size_t)l * 256;
            const float s1 = wave_sum(lp[lane] * lp[64 + lane], lane), s2 = wave_sum(lp[128 + lane] * lp[192 + lane], lane);
            const float lam_init = 0.8f - 0.6f * expf(-0.3f * (float)l);
            const float lam = expf(s1) - expf(s2) + lam_init;
            const float* subw = p.subln_w + (size_t)l * 128;
            for (int m = gw; m < MROWS; m += NGW) combine_row(OATT, subw, lam, 1.f - lam_init, MIX, m, lane);
        }
        GSYNC();
        { PHASE_IDS(); for (int t = gw; t < NBATCH * 128 * 8; t += NGW) four_stage2(Ypr, Ypi, W2, MIX, t >> 10, (t >> 3) & 127, t & 7, lane); }
        GSYNC();
        }
        for (int rep = 0; rep < EXTRA_SYNCS; ++rep) GSYNC();
        { pg8::Gemm g{MIX, Wt_out + (size_t)l * DM * DM, MROWS, DM, DM}; XOrder S; S.init(DM, G, (int)blockIdx.x);
          EpiRes E{p.out, p.ws, l, 2048};
          pg8::gemm_phase<EpiRes, XOrder, true, true>(lds3, g, S, E, wid);
          if (l + 1 < DEPTH) ctx_gemm(MIX, DM, Wt_out + (size_t)l * DM * DM, DM, DM / 32, lds, CEpiRes{p.out, p.ws, l, 2048}, wid); }
        GSYNC();
        { PHASE_IDS(); for (int m = gw; m < MROWS; m += NGW) { const float* mv = modvec(p, l, m);
            ln_mod_row(xrow(p, m), p.ln1_g + (size_t)l * DM, p.ln1_b + (size_t)l * DM, mv + 3072, mv + 4096, H + (size_t)m * DM, lane, true); } }
        GSYNC();
        for (int rep = 0; rep < REP_GEMM; ++rep)
        { pg8::Gemm g{H, Wt_up + (size_t)l * DFF * DM, MROWS, DFF, DM}; XOrder S; S.init(DFF, G, (int)blockIdx.x);
          EpiUp E{HID};
          pg8::gemm_phase<EpiUp, XOrder, true, true>(lds3, g, S, E, wid);
          if (l + 1 < DEPTH) ctx_gemm(H, DM, Wt_up + (size_t)l * DFF * DM, DM, DFF / 32, lds, CEpiUp{HID}, wid); }
        GSYNC();
        { pg8::Gemm g{HID, Wt_dn + (size_t)l * DM * DFF, MROWS, DM, DFF}; XOrder S; S.init(DM, G, (int)blockIdx.x);
          EpiRes E{p.out, p.ws, l, 5120};
          pg8::gemm_phase<EpiRes, XOrder, true, true>(lds3, g, S, E, wid);
          if (l + 1 < DEPTH) ctx_gemm(HID, DFF, Wt_dn + (size_t)l * DM * DFF, DFF, DM / 32, lds, CEpiRes{p.out, p.ws, l, 5120}, wid); }
        GSYNC();
        { PHASE_IDS(); for (int m = gw; m < MROWS; m += NGW) { const bool more = (l + 1 < DEPTH); const float* mv = modvec(p, more ? l + 1 : l, m);
            ln_mod_row(xrow(p, m), p.ln2_g + (size_t)l * DM, p.ln2_b + (size_t)l * DM, more ? mv : nullptr, mv + DM, H + (size_t)m * DM, lane, true); } }
        if (l + 1 < DEPTH) GSYNC();
    }
}

extern "C" void kernel_launch(void* const* d_in, const int* in_sizes, int n_in, void* d_out, int out_size, void* d_ws, size_t ws_size, hipStream_t stream) {
    static int grid = 0;
    if (grid == 0) {
        if (n_in != 18 || out_size != NBATCH * SEQ * DM || ws_size < WS_CTL + CTL_BYTES) { fprintf(stderr, "kernel_launch: unexpected shapes (n_in %d out %d ws %zu)\n", n_in, out_size, ws_size); grid = -1; return; }
        int dev = 0, cus = 0, per_cu = 0;
        hipGetDevice(&dev); hipDeviceGetAttribute(&cus, hipDeviceAttributeMultiprocessorCount, dev);
        if (hipFuncSetAttribute((const void*)mega_fwd, hipFuncAttributeMaxDynamicSharedMemorySize, LDS_BYTES) != hipSuccess) { fprintf(stderr, "kernel_launch: hipFuncSetAttribute failed\n"); grid = -1; return; }
        hipOccupancyMaxActiveBlocksPerMultiprocessor(&per_cu, (const void*)mega_fwd, 512, LDS_BYTES);
        (void)hipGetLastError();
        if (per_cu < 1) per_cu = 1;
        grid = cus;
        if (grid <= 0) grid = 256;
    }
    if (grid < 0) return;
    if (hipMemsetAsync((char*)d_ws + WS_CTL, 0, CTL_BYTES, stream) != hipSuccess) { fprintf(stderr, "kernel_launch: memset of the barrier words failed\n"); return; }
    Params p{};
    const float** f = (const float**)&p;
    for (int i = 0; i < 18; ++i) f[i] = (const float*)d_in[i];
    p.out = (float*)d_out; p.ws = (unsigned char*)d_ws;
    void* args[] = {&p};
    hipError_t e = hipLaunchCooperativeKernel((const void*)mega_fwd, dim3(grid), dim3(512), args, LDS_BYTES, stream);
    if (e != hipSuccess) fprintf(stderr, "cooperative launch failed: %s (grid %d)\n", hipGetErrorString(e), grid);
}
```
